# Optimizing an MI355X kernel written in HIP

```python
import math
import jax, jax.numpy as jnp
from jax import lax
import numpy as np

D_MODEL = 1024
BATCH = 2
SEQ = 16384
DEPTH = 1

N_MEM = 256
HEAD_DIM = 64
DIFF_HEADS = D_MODEL // (2 * HEAD_DIM)
DIFF_V_DIM = 2 * HEAD_DIM
MOBA_HEADS = D_MODEL // (2 * HEAD_DIM)
MOBA_BLOCK = 256
MOBA_TOPK = 3
Q_BLOCK = 128
XATTN_HEADS = 4
XATTN_HEAD_DIM = D_MODEL // XATTN_HEADS
D_FF = 4 * D_MODEL
REL_BUCKETS = 32
REL_MAX_DIST = 128
N_SELF_HEADS = DIFF_HEADS + MOBA_HEADS
LN_EPS = 1e-5
DEEPNORM_ALPHA = (2.0 * DEPTH) ** 0.25
DEEPNORM_BETA = (8.0 * DEPTH) ** -0.25

COL_DQ = DIFF_HEADS * 2 * HEAD_DIM
COL_DK = DIFF_HEADS * 2 * HEAD_DIM
COL_DV = DIFF_HEADS * DIFF_V_DIM
COL_MQ = MOBA_HEADS * HEAD_DIM
COL_MK = MOBA_HEADS * HEAD_DIM
COL_MV = MOBA_HEADS * HEAD_DIM
COL_GATE = 2 * D_MODEL
W_IN_COLS = COL_DQ + COL_DK + COL_DV + COL_MQ + COL_MK + COL_MV + COL_GATE

kernel_name = "hybrid_diffattn_moba_gated_deepnorm"


def _split_points():
    widths = [COL_DQ, COL_DK, COL_DV, COL_MQ, COL_MK, COL_MV]
    return [int(v) for v in np.cumsum(widths)]


def layer_norm(x, g, b):
    xf = x.astype(jnp.float32)
    mu = jnp.mean(xf, axis=-1, keepdims=True)
    var = jnp.mean(jnp.square(xf - mu), axis=-1, keepdims=True)
    return ((xf - mu) * lax.rsqrt(var + LN_EPS) * g.astype(jnp.float32) + b.astype(jnp.float32)).astype(x.dtype)


def rel_bucket(n):
    max_exact = REL_BUCKETS // 2
    nf = jnp.maximum(n, 1).astype(jnp.float32)
    large = max_exact + (jnp.log(nf / max_exact) / math.log(REL_MAX_DIST / max_exact)
                         * (REL_BUCKETS - max_exact)).astype(jnp.int32)
    large = jnp.minimum(large, REL_BUCKETS - 1)
    return jnp.where(n < max_exact, n, large)


def diff_attention(q, k, v, bias_by_dist, lam, sub_g, lam_init):
    B, H, _, S, Dh = q.shape
    n_qb = S // Q_BLOCK
    kpos = jnp.arange(S)
    scale = HEAD_DIM ** -0.5

    def block(i):
        start = i * Q_BLOCK
        qb = lax.dynamic_slice_in_dim(q, start, Q_BLOCK, axis=3)
        qpos = start + jnp.arange(Q_BLOCK)
        dist = qpos[:, None] - kpos[None, :]
        bias = bias_by_dist[:, jnp.clip(dist, 0, S - 1)]
        logits = jnp.einsum('bhmqd,bhmkd->bhmqk', qb, k,
                            preferred_element_type=jnp.float32) * scale + bias[None, :, None]
        logits = jnp.where(dist >= 0, logits, -jnp.inf)
        p = jax.nn.softmax(logits, axis=-1)
        a = p[:, :, 0] - lam * p[:, :, 1]
        return jnp.einsum('bhqk,bhkd->bhqd', a.astype(v.dtype), v)

    out = lax.map(block, jnp.arange(n_qb))
    out = out.transpose(1, 2, 0, 3, 4).reshape(B, H, S, 2 * Dh)
    of = out.astype(jnp.float32)
    of = of * lax.rsqrt(jnp.mean(of * of, axis=-1, keepdims=True) + LN_EPS) * sub_g.astype(jnp.float32)
    of = of * (1.0 - lam_init)
    return of.transpose(0, 2, 1, 3).reshape(B, S, H * 2 * Dh).astype(v.dtype)


def moba_attention(q, k, v, bias_by_dist):
    B, H, S, Dh = q.shape
    nb = max(-(-S // MOBA_BLOCK), MOBA_TOPK)
    pad = nb * MOBA_BLOCK - S
    kp = jnp.pad(k, ((0, 0), (0, 0), (0, pad), (0, 0))).reshape(B, H, nb, MOBA_BLOCK, Dh)
    vp = jnp.pad(v, ((0, 0), (0, 0), (0, pad), (0, 0))).reshape(B, H, nb, MOBA_BLOCK, Dh)
    k_mean = jnp.mean(kp.astype(jnp.float32), axis=3)
    scale = Dh ** -0.5
    blk_ids = jnp.arange(nb)
    offs = jnp.arange(MOBA_BLOCK)
    b_idx = jnp.arange(B)[:, None, None, None]
    h_idx = jnp.arange(H)[None, :, None, None]
    h_idx5 = jnp.arange(H)[None, :, None, None, None]
    rank_valid_ids = jnp.arange(MOBA_TOPK)

    def chunk(i):
        start = i * Q_BLOCK
        cur = start // MOBA_BLOCK
        qc = lax.dynamic_slice_in_dim(q, start, Q_BLOCK, axis=2)
        qpos = start + jnp.arange(Q_BLOCK)
        gate = jnp.einsum('bhqd,bhnd->bhqn', qc.astype(jnp.float32), k_mean)
        gate = jnp.where(blk_ids < cur, gate, -jnp.inf)
        _, sel = lax.top_k(gate, MOBA_TOPK)
        sel_valid = rank_valid_ids < cur
        ks = kp[b_idx, h_idx, sel]
        vs = vp[b_idx, h_idx, sel]
        l_sel = jnp.einsum('bhqd,bhqnkd->bhqnk', qc, ks,
                           preferred_element_type=jnp.float32) * scale
        kpos_sel = sel[..., None] * MOBA_BLOCK + offs
        dist_sel = jnp.clip(qpos[None, None, :, None, None] - kpos_sel, 0, S - 1)
        l_sel = l_sel + bias_by_dist[h_idx5, dist_sel]
        l_sel = jnp.where(sel_valid[None, None, None, :, None], l_sel, -jnp.inf)
        ko = lax.dynamic_index_in_dim(kp, cur, axis=2, keepdims=False)
        vo = lax.dynamic_index_in_dim(vp, cur, axis=2, keepdims=False)
        kpos_own = cur * MOBA_BLOCK + offs
        dist_own = qpos[:, None] - kpos_own[None, :]
        l_own = jnp.einsum('bhqd,bhkd->bhqk', qc, ko,
                           preferred_element_type=jnp.float32) * scale
        l_own = l_own + bias_by_dist[:, jnp.clip(dist_own, 0, S - 1)][None]
        l_own = jnp.where(dist_own >= 0, l_own, -jnp.inf)
        logits = jnp.concatenate([l_sel.reshape(B, H, Q_BLOCK, MOBA_TOPK * MOBA_BLOCK), l_own], axis=-1)
        p = jax.nn.softmax(logits, axis=-1).astype(v.dtype)
        p_sel = p[..., :MOBA_TOPK * MOBA_BLOCK].reshape(B, H, Q_BLOCK, MOBA_TOPK, MOBA_BLOCK)
        p_own = p[..., MOBA_TOPK * MOBA_BLOCK:]
        return (jnp.einsum('bhqnk,bhqnkd->bhqd', p_sel, vs)
                + jnp.einsum('bhqk,bhkd->bhqd', p_own, vo))

    out = lax.map(chunk, jnp.arange(S // Q_BLOCK))
    return out.transpose(1, 0, 3, 2, 4).reshape(B, S, H * Dh)


def memory_cross_attention(h, mem, wq, wk, wv, wo):
    B, S, D = h.shape
    M = mem.shape[1]
    q = (h @ wq).reshape(B, S, XATTN_HEADS, XATTN_HEAD_DIM)
    k = (mem @ wk).reshape(B, M, XATTN_HEADS, XATTN_HEAD_DIM)
    v = (mem @ wv).reshape(B, M, XATTN_HEADS, XATTN_HEAD_DIM)
    logits = jnp.einsum('bshd,bmhd->bhsm', q, k, preferred_element_type=jnp.float32) * (XATTN_HEAD_DIM ** -0.5)
    p = jax.nn.softmax(logits, axis=-1).astype(v.dtype)
    o = jnp.einsum('bhsm,bmhd->bshd', p, v).reshape(B, S, D)
    return o @ wo


def setup_inputs(seed: int = 0) -> dict:
    key = jax.random.key(seed)
    ks = list(jax.random.split(key, 40))
    nrm = jax.random.normal
    D = D_MODEL
    sd = D ** -0.5
    beta = DEEPNORM_BETA
    widths = [COL_DQ, COL_DK, COL_DV, COL_MQ, COL_MK, COL_MV, COL_GATE]
    scales = [sd, sd, sd * beta, sd, sd, sd * beta, sd]
    w_in = jnp.concatenate([nrm(ks[20 + i], (DEPTH, D, w), jnp.float32) * s
                            for i, (w, s) in enumerate(zip(widths, scales))], axis=-1)

    def gain(k, n):
        return 1.0 + 0.02 * nrm(k, n, jnp.float32)

    def bias(k, n):
        return 0.02 * nrm(k, n, jnp.float32)

    return {
        "x": nrm(ks[0], (BATCH, SEQ, D), jnp.float32),
        "mem": nrm(ks[1], (BATCH, N_MEM, D), jnp.float32),
        "ln_in_g": gain(ks[2], (D,)),
        "ln_in_b": bias(ks[3], (D,)),
        "rel_table": 0.3 * nrm(ks[4], (REL_BUCKETS, N_SELF_HEADS), jnp.float32),
        "w_in": w_in,
        "b_gate": 0.01 * nrm(ks[5], (DEPTH, COL_GATE), jnp.float32),
        "lam_q1": 0.1 * nrm(ks[6], (DEPTH, HEAD_DIM), jnp.float32),
        "lam_k1": 0.1 * nrm(ks[7], (DEPTH, HEAD_DIM), jnp.float32),
        "lam_q2": 0.1 * nrm(ks[8], (DEPTH, HEAD_DIM), jnp.float32),
        "lam_k2": 0.1 * nrm(ks[9], (DEPTH, HEAD_DIM), jnp.float32),
        "diff_sub_g": gain(ks[10], (DEPTH, DIFF_V_DIM)),
        "w_br_diff": nrm(ks[11], (DEPTH, COL_DV, D), jnp.float32) * COL_DV ** -0.5,
        "w_br_moba": nrm(ks[12], (DEPTH, COL_MV, D), jnp.float32) * COL_MV ** -0.5,
        "w_out": nrm(ks[13], (DEPTH, D, D), jnp.float32) * sd * beta,
        "ln1_g": gain(ks[14], (DEPTH, D)),
        "ln1_b": bias(ks[15], (DEPTH, D)),
        "wq_x": nrm(ks[16], (DEPTH, D, D), jnp.float32) * sd,
        "wk_x": nrm(ks[17], (DEPTH, D, D), jnp.float32) * sd,
        "wv_x": nrm(ks[18], (DEPTH, D, D), jnp.float32) * sd * beta,
        "wo_x": nrm(ks[19], (DEPTH, D, D), jnp.float32) * sd * beta,
        "ln2_g": gain(ks[30], (DEPTH, D)),
        "ln2_b": bias(ks[31], (DEPTH, D)),
        "w_ff1": nrm(ks[32], (DEPTH, D, D_FF), jnp.float32) * sd * beta,
        "w_ff2": nrm(ks[33], (DEPTH, D_FF, D), jnp.float32) * D_FF ** -0.5 * beta,
        "ln3_g": gain(ks[34], (DEPTH, D)),
        "ln3_b": bias(ks[35], (DEPTH, D)),
    }


def reference(x, mem, ln_in_g, ln_in_b, rel_table, w_in, b_gate, lam_q1, lam_k1, lam_q2, lam_k2,
              diff_sub_g, w_br_diff, w_br_moba, w_out, ln1_g, ln1_b, wq_x, wk_x, wv_x, wo_x,
              ln2_g, ln2_b, w_ff1, w_ff2, ln3_g, ln3_b):
    B, S, D = x.shape
    bias_by_dist = rel_table[rel_bucket(jnp.arange(S))].T.astype(jnp.float32)
    bias_diff = bias_by_dist[:DIFF_HEADS]
    bias_moba = bias_by_dist[DIFF_HEADS:]
    splits = _split_points()

    h = layer_norm(x, ln_in_g, ln_in_b)
    for l in range(DEPTH):
        lam_init = 0.8 - 0.6 * math.exp(-0.3 * l)
        proj = h @ w_in[l]
        dq, dk, dv, mq, mk, mv, g_logit = jnp.split(proj, splits, axis=-1)
        dq = dq.reshape(B, S, DIFF_HEADS, 2, HEAD_DIM).transpose(0, 2, 3, 1, 4)
        dk = dk.reshape(B, S, DIFF_HEADS, 2, HEAD_DIM).transpose(0, 2, 3, 1, 4)
        dv = dv.reshape(B, S, DIFF_HEADS, DIFF_V_DIM).transpose(0, 2, 1, 3)
        lam = (jnp.exp(jnp.sum(lam_q1[l].astype(jnp.float32) * lam_k1[l].astype(jnp.float32)))
               - jnp.exp(jnp.sum(lam_q2[l].astype(jnp.float32) * lam_k2[l].astype(jnp.float32)))
               + lam_init)
        y_diff = diff_attention(dq, dk, dv, bias_diff, lam, diff_sub_g[l], lam_init) @ w_br_diff[l]
        mq = mq.reshape(B, S, MOBA_HEADS, HEAD_DIM).transpose(0, 2, 1, 3)
        mk = mk.reshape(B, S, MOBA_HEADS, HEAD_DIM).transpose(0, 2, 1, 3)
        mv = mv.reshape(B, S, MOBA_HEADS, HEAD_DIM).transpose(0, 2, 1, 3)
        y_moba = moba_attention(mq, mk, mv, bias_moba) @ w_br_moba[l]
        gates = jax.nn.sigmoid(g_logit + b_gate[l])
        g_diff, g_moba = jnp.split(gates, 2, axis=-1)
        mixed = (g_diff * y_diff + g_moba * y_moba) @ w_out[l]
        h = layer_norm(DEEPNORM_ALPHA * h + mixed, ln1_g[l], ln1_b[l])
        xa = memory_cross_attention(h, mem, wq_x[l], wk_x[l], wv_x[l], wo_x[l])
        h = layer_norm(DEEPNORM_ALPHA * h + xa, ln2_g[l], ln2_b[l])
        ff = jnp.square(jax.nn.relu(h @ w_ff1[l])) @ w_ff2[l]
        h = layer_norm(DEEPNORM_ALPHA * h + ff, ln3_g[l], ln3_b[l])
    return h
```

```cpp
#include <hip/hip_runtime.h>
#include <hip/hip_cooperative_groups.h>
#include <hip/hip_bf16.h>
#include <cstdio>
#include <cstdint>
#include <cmath>
namespace cg = cooperative_groups;
__device__ __forceinline__ int fresh_lane() { int l; asm volatile("v_mbcnt_lo_u32_b32 %0, -1, 0\n\tv_mbcnt_hi_u32_b32 %0, -1, %0" : "=v"(l)); return l; }
namespace pg8 {
#define PG8_LAS __attribute__((address_space(3)))
typedef unsigned short bf16_t;
typedef short bf16x8 __attribute__((ext_vector_type(8)));
typedef float f32x4 __attribute__((ext_vector_type(4)));
typedef unsigned u32x4 __attribute__((ext_vector_type(4)));
constexpr int BM = 256, BK = 64, HALF = 128, HTB = HALF * BK * 2  , STAGE_BYTES = 8 * HTB, NXCD = 8, WGM = 8;

__host__ __device__ __forceinline__ int lds_byte(int r, int c) { const int st = (r >> 4) * 2 + (c >> 5), rr = r & 15, cc = c & 31, ob = rr * 64 + cc * 2; return st * 1024 + (ob ^ (((ob >> 9) & 1) << 5)); }
__host__ __device__ __forceinline__ void stage_rc(int b, int& R, int& C) { const int st = b / 1024, sb = b % 1024, swz = sb ^ (((sb >> 9) & 1) << 5); R = (st >> 1) * 16 + swz / 64; C = (st & 1) * 32 + (swz % 64) / 2; }
__host__ __device__ __forceinline__ int perm32(int rho) { const int n = rho >> 4, i = rho & 15; return 8 * (i >> 2) + 4 * n + (i & 3); }

struct Unit { int pm, pn; };
template <int K_, int LDA, int LDB, int APN, int BPN, int BPM, int DIV> struct GemmT { const bf16_t* A; const bf16_t* Bt; int M, N;
    static constexpr int K = K_, lda = LDA, ldb = LDB;
    __device__ __forceinline__ const char* abase(const Unit& u) const { return (const char*)(A + (size_t)u.pm * BM * LDA + (size_t)u.pn * APN); }
    __device__ __forceinline__ const char* bbase(const Unit& u) const { return (const char*)(Bt + (size_t)u.pn * BPN + (size_t)(u.pm / DIV) * BPM); } };

struct StaticOrder {
    int nM, nN, nwg, G, c;
    __host__ __device__ void init(int M, int N, int G_, int c_) { nM = M / BM; nN = N / BM; nwg = nM * nN; G = G_; c = c_; }
    __host__ __device__ bool next(int i, Unit& u) const {
        const long L = (long)i * G + c; if (L >= nwg) return false;
        int wgid = (int)L; { const int q = nwg / NXCD, r = nwg % NXCD, xcd = wgid % NXCD, off = wgid / NXCD; wgid = (xcd < r ? xcd * (q + 1) : r * (q + 1) + (xcd - r) * q) + off; }
        const int nig = WGM * nN, gid = wgid / nig, fm = gid * WGM, gsz = (nM - fm) < WGM ? (nM - fm) : WGM;
        u.pm = fm + ((wgid % nig) % gsz); u.pn = (wgid % nig) / gsz; return true;
    }
    __device__ __forceinline__ void a_ready(const Unit&) const {}
    __device__ __forceinline__ void done(const Unit&) const {}
};

__device__ __forceinline__ unsigned cvt_pk_bf16(float lo, float hi) { unsigned r; asm volatile("v_cvt_pk_bf16_f32 %0, %1, %2" : "=v"(r) : "v"(lo), "v"(hi)); return r; }
template <class Epi, class Sched, bool ALIGN_EPI, bool SP2, class GT>
__device__ __forceinline__ void gemm_phase(PG8_LAS unsigned char* lds, const GT g, const Sched& S, const Epi& E, int wave_s) {
    int tid_ = wave_s * 64 + fresh_lane(); asm volatile("" : "+v"(tid_));
    const int tid = tid_, wid = __builtin_amdgcn_readfirstlane(tid >> 6), lane = tid & 63, wr = wid >> 2, wc = wid & 3, fr = lane & 15, fq = lane >> 4;
    const int K = g.K, nt = K / BK;
    unsigned voffA[2], voffB[2];
#pragma unroll
    for (int i = 0; i < 2; ++i) { int R, C; stage_rc(tid * 16 + i * 8192, R, C); const int Rb = Epi::PERM ? ((R & ~31) + perm32(R & 31)) : R;
        voffA[i] = (unsigned)(R * g.lda + C) * 2u; voffB[i] = (unsigned)(Rb * g.ldb + C) * 2u; }
    const size_t kstep = (size_t)(BK * 2);
    const size_t hA = (size_t)HALF * g.lda * 2, hB = (size_t)HALF * g.ldb * 2;
    const unsigned ldsw = (unsigned)wid * 1024u;
    const int aoff = lds_byte(wr * 64 + fr, fq * 8), boff = lds_byte(wc * 32 + fr, fq * 8);
#define PG8_SA(b, h) (((b) * 2 + (h)) * HTB)
#define PG8_SB(b, h) ((4 + (b) * 2 + (h)) * HTB)
#define PG8_STAGE(bufoff, gbase, voff) do { _Pragma("unroll") for (int _i = 0; _i < 2; ++_i) \
        __builtin_amdgcn_global_load_lds((const unsigned*)((const char*)(gbase) + (voff)[_i]), (PG8_LAS unsigned*)(lds + (bufoff) + ldsw + _i * 8192), 16, 0, 0); } while (0)
#define PG8_LDA(dst, b, h) do { _Pragma("unroll") for (int m = 0; m < 4; ++m) _Pragma("unroll") for (int k = 0; k < 2; ++k) dst[m][k] = *(const PG8_LAS bf16x8*)(lds + PG8_SA(b, h) + aoff + m * 2048 + k * 1024); } while (0)
#define PG8_LDB(dst, b, h) do { _Pragma("unroll") for (int n = 0; n < 2; ++n) _Pragma("unroll") for (int k = 0; k < 2; ++k) dst[n][k] = *(const PG8_LAS bf16x8*)(lds + PG8_SB(b, h) + boff + n * 2048 + k * 1024); } while (0)
#define PG8_MMA(ai, bj, At, Bt) do { __builtin_amdgcn_s_setprio(1); _Pragma("unroll") for (int m = 0; m < 4; ++m) _Pragma("unroll") for (int n = 0; n < 2; ++n) _Pragma("unroll") for (int k = 0; k < 2; ++k) \
        acc[ai][bj][m][n] = __builtin_amdgcn_mfma_f32_16x16x32_bf16(Bt[n][k], At[m][k], acc[ai][bj][m][n], 0, 0, 0); __builtin_amdgcn_s_setprio(0); } while (0)
#define PG8_WAIT_V(n) asm volatile("s_waitcnt vmcnt(" #n ")" ::: "memory")
#define PG8_WAIT_L(n) asm volatile("s_waitcnt lgkmcnt(" #n ")" ::: "memory")
#define PG8_BAR __builtin_amdgcn_s_barrier()
#define PG8_SCHED __builtin_amdgcn_sched_barrier(0)
    Unit cur, nxt; int ui = 0;
    if (!S.next(0, cur)) return;
    f32x4 acc[2][2][4][2];
#pragma unroll
    for (int a = 0; a < 2; ++a)
#pragma unroll
        for (int b = 0; b < 2; ++b)
#pragma unroll
            for (int m = 0; m < 4; ++m)
#pragma unroll
                for (int n = 0; n < 2; ++n) acc[a][b][m][n] = (f32x4){0.f, 0.f, 0.f, 0.f};
    bf16x8 At[4][2], B0[2][2], B1[2][2];
    const char* cA = g.abase(cur); const char* cB = g.bbase(cur);
    S.a_ready(cur);
    if constexpr (SP2) {
        PG8_STAGE(PG8_SB(0, 0), cB, voffB); PG8_STAGE(PG8_SB(0, 1), cB + hB, voffB); PG8_STAGE(PG8_SA(0, 0), cA, voffA); PG8_STAGE(PG8_SA(0, 1), cA + hA, voffA);
        if (wr == 1) PG8_BAR;
        PG8_WAIT_V(2); PG8_BAR;
        PG8_STAGE(PG8_SB(1, 0), cB + kstep, voffB); PG8_STAGE(PG8_SA(1, 0), cA + kstep, voffA); PG8_STAGE(PG8_SB(1, 1), cB + hB + kstep, voffB);
        PG8_WAIT_V(6); PG8_BAR;
    } else {
        PG8_STAGE(PG8_SB(0, 0), cB, voffB); PG8_STAGE(PG8_SA(0, 0), cA, voffA); PG8_STAGE(PG8_SB(0, 1), cB + hB, voffB); PG8_STAGE(PG8_SA(0, 1), cA + hA, voffA);
        if (wr == 1) PG8_BAR;
        PG8_WAIT_V(4); PG8_BAR;
        PG8_STAGE(PG8_SB(1, 0), cB + kstep, voffB); PG8_STAGE(PG8_SA(1, 0), cA + kstep, voffA); PG8_STAGE(PG8_SB(1, 1), cB + hB + kstep, voffB);
        PG8_WAIT_V(6); PG8_BAR;
    }
    for (;;) {
        const bool has_next = S.next(ui + 1, nxt);
        const char* nA = has_next ? g.abase(nxt) : cA; const char* nB = has_next ? g.bbase(nxt) : cB;
        for (int t = 0; t < nt; t += 2) {
            const bool last = (t == nt - 2);
            const char* a1 = cA + (size_t)(t + 1) * kstep;
            const char* a2 = last ? nA : cA + (size_t)(t + 2) * kstep; const char* b2 = last ? nB : cB + (size_t)(t + 2) * kstep;
            const char* a3 = a2 + kstep; const char* b3 = b2 + kstep;
            if (last && has_next) S.a_ready(nxt);
            if constexpr (SP2) {
            PG8_LDB(B0, 0, 0); PG8_LDB(B1, 0, 1); PG8_SCHED; PG8_LDA(At, 0, 0); PG8_STAGE(PG8_SA(1, 1), a1 + hA, voffA);
            PG8_WAIT_V(8); PG8_WAIT_L(0); PG8_BAR; PG8_MMA(0, 0, At, B0); PG8_MMA(0, 1, At, B1); PG8_BAR; PG8_SCHED;
            PG8_LDA(At, 0, 1); PG8_STAGE(PG8_SB(0, 0), b2, voffB); PG8_STAGE(PG8_SB(0, 1), b2 + hB, voffB); PG8_STAGE(PG8_SA(0, 0), a2, voffA);
            PG8_WAIT_V(8); PG8_WAIT_L(0); PG8_BAR; PG8_MMA(1, 0, At, B0); PG8_MMA(1, 1, At, B1); PG8_BAR; PG8_SCHED;
            PG8_LDB(B0, 1, 0); PG8_LDB(B1, 1, 1); PG8_SCHED; PG8_LDA(At, 1, 0); PG8_STAGE(PG8_SA(0, 1), a2 + hA, voffA);
            PG8_WAIT_V(8); PG8_WAIT_L(0); PG8_BAR; PG8_MMA(0, 0, At, B0); PG8_MMA(0, 1, At, B1); PG8_BAR; PG8_SCHED;
            PG8_LDA(At, 1, 1); PG8_STAGE(PG8_SB(1, 0), b3, voffB); PG8_STAGE(PG8_SB(1, 1), b3 + hB, voffB); PG8_STAGE(PG8_SA(1, 0), a3, voffA);
            PG8_WAIT_V(8); PG8_WAIT_L(0); PG8_BAR; PG8_MMA(1, 0, At, B0); PG8_MMA(1, 1, At, B1); PG8_BAR; PG8_SCHED;
            } else {
            PG8_LDB(B0, 0, 0); PG8_SCHED; PG8_LDA(At, 0, 0); PG8_STAGE(PG8_SA(1, 1), a1 + hA, voffA);
            PG8_WAIT_L(8); PG8_BAR; PG8_WAIT_L(0); PG8_MMA(0, 0, At, B0); PG8_BAR; PG8_SCHED;
            PG8_LDB(B1, 0, 1); PG8_STAGE(PG8_SB(0, 0), b2, voffB);
            PG8_BAR; PG8_WAIT_L(0); PG8_MMA(0, 1, At, B1); PG8_BAR;
            PG8_LDA(At, 0, 1); PG8_STAGE(PG8_SA(0, 0), a2, voffA);
            PG8_BAR; PG8_WAIT_L(0); PG8_MMA(1, 0, At, B0); PG8_BAR; PG8_SCHED;
            PG8_STAGE(PG8_SB(0, 1), b2 + hB, voffB);
            PG8_WAIT_V(6); PG8_BAR; PG8_MMA(1, 1, At, B1); PG8_BAR;
            PG8_LDB(B0, 1, 0); PG8_SCHED; PG8_LDA(At, 1, 0); PG8_STAGE(PG8_SA(0, 1), a2 + hA, voffA);
            PG8_WAIT_L(8); PG8_BAR; PG8_WAIT_L(0); PG8_MMA(0, 0, At, B0); PG8_BAR; PG8_SCHED;
            PG8_LDB(B1, 1, 1); PG8_STAGE(PG8_SB(1, 0), b3, voffB);
            PG8_BAR; PG8_WAIT_L(0); PG8_MMA(0, 1, At, B1); PG8_BAR;
            PG8_LDA(At, 1, 1); PG8_STAGE(PG8_SA(1, 0), a3, voffA);
            PG8_BAR; PG8_WAIT_L(0); PG8_MMA(1, 0, At, B0); PG8_BAR; PG8_SCHED;
            PG8_STAGE(PG8_SB(1, 1), b3 + hB, voffB);
            PG8_WAIT_V(6); PG8_BAR; PG8_MMA(1, 1, At, B1); PG8_BAR;
            }
        }
        if constexpr (ALIGN_EPI) { if (wr == 0) PG8_BAR; }
        if constexpr (!Epi::AFTER_DRAIN) { E(acc, cur, wr, wc, fr, fq); S.done(cur); }
        if (!has_next) break;
#pragma unroll
        for (int a = 0; a < 2; ++a)
#pragma unroll
            for (int b = 0; b < 2; ++b)
#pragma unroll
                for (int m = 0; m < 4; ++m)
#pragma unroll
                    for (int n = 0; n < 2; ++n) acc[a][b][m][n] = (f32x4){0.f, 0.f, 0.f, 0.f};
        cur = nxt; cA = nA; cB = nB; ++ui;
        if constexpr (ALIGN_EPI) { if (wr == 1) PG8_BAR; }
    }
    PG8_WAIT_V(0);
    if constexpr (!ALIGN_EPI) { if (wr == 0) PG8_BAR; }
    PG8_BAR;
    if constexpr (Epi::AFTER_DRAIN) { E.fused(acc, cur, wr, wc, fr, fq, lds, wid, lane); S.done(cur); }
#undef PG8_SA
#undef PG8_SB
#undef PG8_STAGE
#undef PG8_LDA
#undef PG8_LDB
#undef PG8_MMA
#undef PG8_WAIT_V
#undef PG8_WAIT_L
#undef PG8_BAR
#undef PG8_SCHED
}
}
namespace attn_body {
using bf16=__hip_bfloat16;
using bf16x8=__attribute__((ext_vector_type(8)))short;
using s16x4=__attribute__((ext_vector_type(4)))short;
using f32x16=__attribute__((ext_vector_type(16)))float;
using u32x4=__attribute__((ext_vector_type(4)))unsigned;
constexpr int SEQ=16384,D=64;
constexpr int NW=8,QBLK=32,QB=QBLK*NW,KVBLK=64,NQB=SEQ/QB;
constexpr int TBL_OFF=98304, TBLW=384;
__device__ __forceinline__ int crow(int r,int hi){return (r&3)+8*(r>>2)+4*hi;}
#define SBAR() __builtin_amdgcn_sched_barrier(0)
__device__ __forceinline__ void cmask(f32x16&p0,f32x16&p1,int jb,int qrel,int hi){
  const float NEG=-INFINITY; int kb=64*jb+4*hi;
  #pragma unroll
  for(int r=0;r<16;++r){int kv=kb+(r&3)+8*(r>>2); if(kv>qrel)p0[r]=NEG; if(kv+32>qrel)p1[r]=NEG;}
}

constexpr int NSLOT=3, SLOTB=8192;
constexpr int LDS_K=0, LDS_V=NSLOT*SLOTB, LDS_WS=2*NSLOT*SLOTB, LDS_OST=LDS_WS+NW*64*4, LDS_BYTES=LDS_OST+NW*4096;
constexpr float C2=0.125f*1.4426950408889634f;
__device__ __forceinline__ void glds16(const void*gsrc,unsigned lds_dst){unsigned keep;
  asm volatile("s_mov_b32 %0, m0\n\ts_mov_b32 m0, %2\n\ts_nop 0\n\tglobal_load_lds_dwordx4 %1, off\n\ts_mov_b32 m0, %0":"=&s"(keep):"v"(gsrc),"s"(lds_dst):"memory");}
__device__ __forceinline__ float max3f(float a,float b,float c){float r;asm("v_max3_f32 %0, %1, %2, %3":"=v"(r):"v"(a),"v"(b),"v"(c));return r;}
__device__ __forceinline__ float max2f(float a,float b){float r;asm("v_max_f32_e32 %0, %1, %2":"=v"(r):"v"(a),"v"(b));return r;}
__device__ __forceinline__ float fadd_s(float a,float b){float r;asm("v_add_f32_e32 %0, %1, %2":"=v"(r):"v"(a),"v"(b));return r;}
__device__ __forceinline__ float fsub_s(float a,float b){float r;asm("v_sub_f32_e32 %0, %1, %2":"=v"(r):"v"(a),"v"(b));return r;}
typedef float f32x2_t __attribute__((ext_vector_type(2))); typedef __bf16 bf16x2_t __attribute__((ext_vector_type(2)));
__device__ __forceinline__ unsigned cvtpk_s(float lo,float hi){f32x2_t v={lo,hi};bf16x2_t b=__builtin_convertvector(v,bf16x2_t);return __builtin_bit_cast(unsigned,b);}
#define WAIT_BAR(N) asm volatile("s_waitcnt vmcnt(" #N ") lgkmcnt(0)\n\ts_barrier":::"memory")

__device__ __forceinline__ void qkt(f32x16&p0,f32x16&p1,const char*Kslot,const bf16x8*qr,const f32x16&negm,int r32,int hi){
  const char*kb=Kslot+hi*1024+r32*16;
  #pragma unroll
  for(int d0=0;d0<4;++d0){
    const bf16x8 b0=*reinterpret_cast<const bf16x8*>(kb+d0*2048);
    const bf16x8 b1=*reinterpret_cast<const bf16x8*>(kb+d0*2048+512);
    if(d0==0){p0=__builtin_amdgcn_mfma_f32_32x32x16_bf16(b0,qr[0],negm,0,0,0);p1=__builtin_amdgcn_mfma_f32_32x32x16_bf16(b1,qr[0],negm,0,0,0);}
    else{p0=__builtin_amdgcn_mfma_f32_32x32x16_bf16(b0,qr[d0],p0,0,0,0);p1=__builtin_amdgcn_mfma_f32_32x32x16_bf16(b1,qr[d0],p1,0,0,0);}}
}
typedef __attribute__((address_space(3))) const char* lds_cptr;
typedef short v4i16_t __attribute__((ext_vector_type(4)));
__device__ __forceinline__ void kload8(bf16x8*kf,lds_cptr kp){
  kf[0]=*(const __attribute__((address_space(3))) bf16x8*)(kp);      kf[1]=*(const __attribute__((address_space(3))) bf16x8*)(kp+512);
  kf[2]=*(const __attribute__((address_space(3))) bf16x8*)(kp+2048); kf[3]=*(const __attribute__((address_space(3))) bf16x8*)(kp+2560);
  kf[4]=*(const __attribute__((address_space(3))) bf16x8*)(kp+4096); kf[5]=*(const __attribute__((address_space(3))) bf16x8*)(kp+4608);
  kf[6]=*(const __attribute__((address_space(3))) bf16x8*)(kp+6144); kf[7]=*(const __attribute__((address_space(3))) bf16x8*)(kp+6656);
}
__device__ __forceinline__ void kload2(bf16x8*kf,lds_cptr kp,int j){ kf[2*j]=*(const __attribute__((address_space(3))) bf16x8*)(kp+j*2048); kf[2*j+1]=*(const __attribute__((address_space(3))) bf16x8*)(kp+j*2048+512); }
__device__ __forceinline__ s16x4 vtr(lds_cptr p){ return __builtin_bit_cast(s16x4,__builtin_amdgcn_ds_read_tr16_b64_v4i16((__attribute__((address_space(3))) v4i16_t*)p)); }
__device__ __forceinline__ float rowmax(const f32x16&p0,const f32x16&p1){
  float a=max3f(p0[0],p0[1],p1[0]),b=max3f(p0[2],p0[3],p1[1]);a=max3f(a,p1[2],p1[3]);
  #pragma unroll
  for(int r=4;r<16;r+=4){a=max3f(a,p0[r],p0[r+1]);b=max3f(b,p0[r+2],p0[r+3]);a=max3f(a,p1[r],p1[r+1]);b=max3f(b,p1[r+2],p1[r+3]);}
  const float m=max2f(a,b);
  auto rr=__builtin_amdgcn_permlane32_swap(__float_as_uint(m),__float_as_uint(m),false,false);
  return max2f(__uint_as_float(rr[0]),__uint_as_float(rr[1]));
}
__device__ __forceinline__ void pv(f32x16*o,int vb,bf16x8 pa0,bf16x8 pa1,bf16x8 pa2,bf16x8 pa3){
  #pragma unroll
  for(int d0=0;d0<2;++d0){s16x4 lo[4],hi[4];
    #pragma unroll
    for(int ks=0;ks<4;++ks){
      asm volatile("ds_read_b64_tr_b16 %0,%1 offset:%c2":"=&v"(lo[ks]):"v"(vb),"i"(d0*4096+ks*1024):"memory");
      asm volatile("ds_read_b64_tr_b16 %0,%1 offset:%c2":"=&v"(hi[ks]):"v"(vb),"i"(d0*4096+ks*1024+512):"memory");}
    asm volatile("s_waitcnt lgkmcnt(0)":::"memory");SBAR();
    #define PK(k) (bf16x8){lo[k][0],lo[k][1],lo[k][2],lo[k][3],hi[k][0],hi[k][1],hi[k][2],hi[k][3]}
    o[d0]=__builtin_amdgcn_mfma_f32_32x32x16_bf16(pa0,PK(0),o[d0],0,0,0);
    o[d0]=__builtin_amdgcn_mfma_f32_32x32x16_bf16(pa1,PK(1),o[d0],0,0,0);
    o[d0]=__builtin_amdgcn_mfma_f32_32x32x16_bf16(pa2,PK(2),o[d0],0,0,0);
    o[d0]=__builtin_amdgcn_mfma_f32_32x32x16_bf16(pa3,PK(3),o[d0],0,0,0);
    #undef PK
  }
}

#ifndef ATTN_STORE16
#define ATTN_STORE16(p,v) (*(u32x4*)(p)=(v))
#endif
template<int THRL,int MODE,int QP,int KP,int VP,int OP> __device__ __forceinline__ void attn_unit(int b,int qb,const bf16*Q,const bf16*__restrict__ K,const bf16*__restrict__ V,bf16*O,char*shm,const float*btab,const bf16*km,int wave_s){
  int tid_=wave_s*64+fresh_lane(); asm volatile("":"+v"(tid_));
  const int tid=tid_,lane=tid&63,r32=lane&31,hi=lane>>5; const int wid=wave_s;
  const long rowbase=(long)b*SEQ; const int q0=qb*QB;
  const bf16*Qw=Q+(rowbase+q0+wid*QBLK)*QP;
  const bf16*Kh=K+rowbase*KP,*Vh=V+rowbase*VP;
  const unsigned lds0=(unsigned)(uintptr_t)shm;
  float*wsf=(float*)(shm+LDS_WS)+wid*64;
  const bf16*ksrc=Kh+(long)lane*KP+wid*8;
  const bf16*vsrc=Vh+(long)(16*(wid&3)+(lane>>2))*VP+(wid>>2)*32+(lane&3)*8;
  const unsigned kdst=lds0+LDS_K+wid*1024, vdst=lds0+LDS_V+wid*1024;
  #define DMA_K(t,slot) glds16(ksrc+(long)(t)*KVBLK*KP,(unsigned)__builtin_amdgcn_readfirstlane(kdst+(slot)))
  #define DMA_V(t,slot) glds16(vsrc+(long)(t)*KVBLK*VP,(unsigned)__builtin_amdgcn_readfirstlane(vdst+(slot)))
  const int vb0=(int)(lds0+LDS_V)+((lane>>4)&1)*32+(lane&3)*8+(4*hi+((lane&15)>>2))*64;
  const char*Kbase=shm+LDS_K; bf16x8 kf[8];
  const lds_cptr shm3=(lds_cptr)shm; const lds_cptr kp0=shm3+LDS_K+hi*1024+r32*16; const lds_cptr vp0=shm3+LDS_V+((lane>>4)&1)*32+(lane&3)*8+(4*hi+((lane&15)>>2))*64;
  const int NT=(q0+QB)/KVBLK;
  DMA_K(0,0);DMA_V(0,0);DMA_K(1,SLOTB);
  bf16x8 qr[4];
  #pragma unroll
  for(int d0=0;d0<4;++d0)qr[d0]=*reinterpret_cast<const bf16x8*>(&Qw[(long)r32*QP+d0*16+hi*8]);
  const float B31=__builtin_bit_cast(float,__builtin_amdgcn_readfirstlane(__builtin_bit_cast(int,btab[TBLW-1])));
  { __attribute__((address_space(3))) float* tw=(__attribute__((address_space(3))) float*)(shm3+TBL_OFF); if(tid<TBLW)tw[tid]=btab[tid]-B31; }
  const __attribute__((address_space(3))) float* tbl=(const __attribute__((address_space(3))) float*)(shm3+TBL_OFF);
  const int qrel=wid*QBLK+r32;
  __attribute__((address_space(3))) unsigned* selw=(__attribute__((address_space(3))) unsigned*)(shm3+TBL_OFF+2048);
  unsigned selpk=0xffffffu;
  if constexpr(MODE==1){
    f32x16 g0=f32x16{},g1=f32x16{};
    #pragma unroll
    for(int d0=0;d0<4;++d0){ const bf16x8 k0=*reinterpret_cast<const bf16x8*>(&km[r32*64+d0*16+hi*8]); const bf16x8 k1=*reinterpret_cast<const bf16x8*>(&km[(32+r32)*64+d0*16+hi*8]);
      g0=__builtin_amdgcn_mfma_f32_32x32x16_bf16(k0,qr[d0],g0,0,0,0); g1=__builtin_amdgcn_mfma_f32_32x32x16_bf16(k1,qr[d0],g1,0,0,0); }
    const int cur=qb;
    #pragma unroll
    for(int r=0;r<16;++r){ const int bk=crow(r,hi); if(bk>=cur)g0[r]=-INFINITY; if(bk+32>=cur)g1[r]=-INFINITY; }
    selpk=0u;
    #pragma unroll
    for(int it=0;it<3;++it){
      float bv=-INFINITY; int bi=255;
      #pragma unroll
      for(int r=0;r<16;++r){ const int bk=crow(r,hi); if(g0[r]>bv||(g0[r]==bv&&g0[r]>-INFINITY&&bk<bi)){bv=g0[r];bi=bk;} }
      #pragma unroll
      for(int r=0;r<16;++r){ const int bk=crow(r,hi)+32; if(g1[r]>bv||(g1[r]==bv&&g1[r]>-INFINITY&&bk<bi)){bv=g1[r];bi=bk;} }
      const float ov=__shfl_xor(bv,32); const int oi=__shfl_xor(bi,32);
      if(ov>bv||(ov==bv&&oi<bi)){bv=ov;bi=oi;}
      selpk|=(unsigned)bi<<(8*it);
      #pragma unroll
      for(int r=0;r<16;++r){ const int bk=crow(r,hi); if(bk==bi)g0[r]=-INFINITY; if(bk+32==bi)g1[r]=-INFINITY; }
    }
    selw[qrel]=selpk;
  }
  float mhat=0.f,l_reg=0.f;f32x16 o[2];o[0]=f32x16{};o[1]=f32x16{};f32x16 negm;
  #pragma unroll
  for(int r=0;r<16;++r)negm[r]=B31;
  asm volatile("":"+v"(negm));
  #define ROWMASK(P0,P1,t) do{ if constexpr(MODE==1){ const unsigned bk_=(unsigned)((t)>>2), sp_=selw[qrel]; const bool sel_=(bk_==(sp_&255u))||(bk_==((sp_>>8)&255u))||(bk_==((sp_>>16)&255u)); \
      _Pragma("unroll") for(int r=0;r<16;++r){P0[r]=sel_?P0[r]:-INFINITY;P1[r]=sel_?P1[r]:-INFINITY;} } }while(0)
  #define NEARB(P0,P1,t) do{ const int tb_=(t)-(NT-6); if(tb_>=0){ const int base_=qrel+128-64*tb_-4*hi; \
      _Pragma("unroll") for(int r=0;r<16;++r){ const int d0_=base_-((r&3)+8*(r>>2)), d1_=d0_-32; \
        P0[r]=(d0_>=0)?P0[r]+tbl[d0_<0?0:d0_]:-INFINITY; P1[r]=(d1_>=0)?P1[r]+tbl[d1_<0?0:d1_]:-INFINITY; } } }while(0)
  #define CMASK(P0,P1,t) do{ if((t)<NT-4){ROWMASK(P0,P1,t);} NEARB(P0,P1,t); }while(0)
  bool resc=false;
  #define START(P0,P1) do{ const float rm=rowmax(P0,P1); resc=false; \
    { const float dl=__builtin_fmaxf(rm,0.f); mhat=fadd_s(mhat,dl); \
      _Pragma("unroll") for(int r=0;r<16;++r){P0[r]=fsub_s(P0[r],dl);P1[r]=fsub_s(P1[r],dl);} \
      _Pragma("unroll") for(int r=0;r<16;++r)negm[r]=B31-mhat; asm volatile("":"+v"(negm)); } \
    _Pragma("unroll") for(int r=0;r<16;++r)P0[r]=__builtin_amdgcn_exp2f(P0[r]); }while(0)
  #define RESC() do{ if(resc){ asm volatile("s_waitcnt lgkmcnt(0)":::"memory"); \
      _Pragma("unroll") for(int d_=0;d_<2;++d_) _Pragma("unroll") for(int r=0;r<16;++r)o[d_][r]*=wsf[crow(r,hi)]; } }while(0)
  f32x16 pA0,pA1,pB0,pB1;
  int sl_prev=0,sl_cur=0,sl_next=SLOTB;
  #define ROT() do{sl_prev=sl_cur;sl_cur=sl_next;sl_next=(sl_next==(NSLOT-1)*SLOTB)?0:sl_next+SLOTB;}while(0)
  DMA_K(2,2*SLOTB);
  WAIT_BAR(3);
  qkt(pA0,pA1,Kbase,qr,negm,r32,hi);asm volatile("s_nop 15\n\ts_nop 7":"+v"(pA0),"+v"(pA1));CMASK(pA0,pA1,0);
  START(pA0,pA1);
  _Pragma("unroll") for(int r=0;r<16;++r)pA1[r]=__builtin_amdgcn_exp2f(pA1[r]);
  WAIT_BAR(0);
  DMA_K(3,0);DMA_V(1,SLOTB);
  ROT();
  kload8(kf,kp0+sl_cur);
  WAIT_BAR(2);
  s16x4 vlo[8],vhi[8]; u32x4 pw0,pw1,pw2,pw3;
  #define PKW(P,B) cvtpk_s(P[B],P[B+1])
  #define PAF(k) __builtin_bit_cast(bf16x8,pw##k)
  #define VFR(i) (bf16x8){vlo[i][0],vlo[i][1],vlo[i][2],vlo[i][3],vhi[i][0],vhi[i][1],vhi[i][2],vhi[i][3]}
  #define PIN(x) asm volatile("":"+v"(x))
  #define MX3(a,b,c) __builtin_fmaxf(__builtin_fmaxf((a),(b)),(c))
  #define GAPA(MF,A0,A1,A2,A3,W0,W1,PW) do{ MF; sacc+=A0; sacc+=A1; sacc+=A2; sacc+=A3; PIN(sacc); W0; W1; PIN(PW); SBAR(); }while(0)
  #define EX(v) __builtin_amdgcn_exp2f(v)
  #define GAPB(MF,X,B) do{ MF; X[B]=EX(X[B]); X[B+1]=EX(X[B+1]); X[B+2]=EX(X[B+2]); X[B+3]=EX(X[B+3]); PIN(X); SBAR(); }while(0)
  #define VRD(i) do{ vlo[i]=vtr(vp_+(((i)>>2)*4096+((i)&3)*1024)); vhi[i]=vtr(vp_+(((i)>>2)*4096+((i)&3)*1024+512)); }while(0)
  #define KRD(G,j) do{ if(G){ kload2(kf,kp0+sl_next,j); SBAR(); } }while(0)
  #define STEP(C0,C1,P0,P1,t,GK,GV,GL) do{ SBAR(); \
    const lds_cptr vp_=vp0+sl_prev; \
    VRD(0); SBAR(); float sacc=(P0[0]+P0[1]); \
    GAPA(C0=__builtin_amdgcn_mfma_f32_32x32x16_bf16(kf[0],qr[0],negm,0,0,0), P0[2],P0[3],P0[4],P0[5],     pw0[0]=PKW(P0,0), pw0[1]=PKW(P0,2), pw0); \
    VRD(4); SBAR(); GAPA(C1=__builtin_amdgcn_mfma_f32_32x32x16_bf16(kf[1],qr[0],negm,0,0,0), P0[6],P0[7],P0[8],P0[9],     pw0[2]=PKW(P0,4), pw0[3]=PKW(P0,6), pw0); \
    VRD(1); SBAR(); GAPA(C0=__builtin_amdgcn_mfma_f32_32x32x16_bf16(kf[2],qr[1],C0,0,0,0),   P0[10],P0[11],P0[12],P0[13], pw1[0]=PKW(P0,8), pw1[1]=PKW(P0,10), pw1); \
    VRD(5); SBAR(); GAPA(C1=__builtin_amdgcn_mfma_f32_32x32x16_bf16(kf[3],qr[1],C1,0,0,0),   P0[14],P0[15],P1[0],P1[1],   pw1[2]=PKW(P0,12),pw1[3]=PKW(P0,14), pw1); \
    VRD(2); SBAR(); GAPA(C0=__builtin_amdgcn_mfma_f32_32x32x16_bf16(kf[4],qr[2],C0,0,0,0),   P1[2],P1[3],P1[4],P1[5],     pw2[0]=PKW(P1,0), pw2[1]=PKW(P1,2), pw2); \
    VRD(6); SBAR(); GAPA(C1=__builtin_amdgcn_mfma_f32_32x32x16_bf16(kf[5],qr[2],C1,0,0,0),   P1[6],P1[7],P1[8],P1[9],     pw2[2]=PKW(P1,4), pw2[3]=PKW(P1,6), pw2); \
    VRD(3); SBAR(); GAPA(C0=__builtin_amdgcn_mfma_f32_32x32x16_bf16(kf[6],qr[3],C0,0,0,0),   P1[10],P1[11],P1[12],P1[13], pw3[0]=PKW(P1,8), pw3[1]=PKW(P1,10), pw3); \
    VRD(7); SBAR(); GAPA(C1=__builtin_amdgcn_mfma_f32_32x32x16_bf16(kf[7],qr[3],C1,0,0,0),   P1[14],P1[15],0.f,0.f,       pw3[2]=PKW(P1,12),pw3[3]=PKW(P1,14), pw3); \
    l_reg+=sacc; \
    if(GK){DMA_K((t)+3,sl_cur);} if(GV){DMA_V((t)+1,sl_next);} \
    CMASK(C0,C1,t); \
    { float a=MX3(C0[0],C0[1],C1[0]),b=MX3(C0[2],C0[3],C1[1]); a=MX3(a,C1[2],C1[3]); \
      _Pragma("unroll") for(int r=4;r<16;r+=4){a=MX3(a,C0[r],C0[r+1]);b=MX3(b,C0[r+2],C0[r+3]);a=MX3(a,C1[r],C1[r+1]);b=MX3(b,C1[r+2],C1[r+3]);} \
      float rm=__builtin_fmaxf(a,b); { auto rr=__builtin_amdgcn_permlane32_swap(__float_as_uint(rm),__float_as_uint(rm),false,false); rm=__builtin_fmaxf(__uint_as_float(rr[0]),__uint_as_float(rr[1])); } \
      resc=false; \
      if(__builtin_expect(__any(rm>(float)THRL),0)){ const float dl=__builtin_fmaxf(rm,0.f); mhat+=dl; \
        _Pragma("unroll") for(int r=0;r<16;++r){C0[r]-=dl;C1[r]-=dl;} \
        _Pragma("unroll") for(int r=0;r<16;++r)negm[r]=B31-mhat; asm volatile("":"+v"(negm)); \
        const float f=__builtin_amdgcn_exp2f(-dl); l_reg*=f; if(hi==0)wsf[r32]=f; resc=true; } } \
    SBAR(); \
    GAPB(o[0]=__builtin_amdgcn_mfma_f32_32x32x16_bf16(PAF(0),VFR(0),o[0],0,0,0), C0,0); \
    GAPB(o[1]=__builtin_amdgcn_mfma_f32_32x32x16_bf16(PAF(0),VFR(4),o[1],0,0,0), C0,4); \
    KRD(GL,0); GAPB(o[0]=__builtin_amdgcn_mfma_f32_32x32x16_bf16(PAF(1),VFR(1),o[0],0,0,0), C0,8); \
    KRD(GL,1); GAPB(o[1]=__builtin_amdgcn_mfma_f32_32x32x16_bf16(PAF(1),VFR(5),o[1],0,0,0), C0,12); \
    KRD(GL,2); GAPB(o[0]=__builtin_amdgcn_mfma_f32_32x32x16_bf16(PAF(2),VFR(2),o[0],0,0,0), C1,0); \
    KRD(GL,3); GAPB(o[1]=__builtin_amdgcn_mfma_f32_32x32x16_bf16(PAF(2),VFR(6),o[1],0,0,0), C1,4); \
    GAPB(o[0]=__builtin_amdgcn_mfma_f32_32x32x16_bf16(PAF(3),VFR(3),o[0],0,0,0), C1,8); \
    GAPB(o[1]=__builtin_amdgcn_mfma_f32_32x32x16_bf16(PAF(3),VFR(7),o[1],0,0,0), C1,12); \
    }while(0)
  int t=1;
  #undef CMASK
  #define CMASK(P0,P1,t) ROWMASK(P0,P1,t)
  for(;t+7<NT;t+=2){
    STEP(pB0,pB1,pA0,pA1,t,true,true,true);     WAIT_BAR(2); RESC(); ROT();
    STEP(pA0,pA1,pB0,pB1,t+1,true,true,true);   WAIT_BAR(2); RESC(); ROT();
  }
  #undef CMASK
  #define CMASK(P0,P1,t) do{ if((t)<NT-4){ROWMASK(P0,P1,t);} NEARB(P0,P1,t); }while(0)
  #define ENDW(tt) do{ if((tt)+3<NT){WAIT_BAR(2);} else if((tt)+2<NT){WAIT_BAR(1);} else {WAIT_BAR(0);} }while(0)
  for(;t+1<NT;t+=2){
    STEP(pB0,pB1,pA0,pA1,t,(t+3<NT),(t+1<NT),(t+1<NT));       ENDW(t);   RESC(); ROT();
    STEP(pA0,pA1,pB0,pB1,t+1,(t+4<NT),(t+2<NT),(t+2<NT));     ENDW(t+1); RESC(); ROT();
  }
  STEP(pB0,pB1,pA0,pA1,NT-1,false,false,false); RESC();
  { float sacc=pB0[0]+pB0[1]; _Pragma("unroll") for(int r=2;r<16;++r)sacc+=pB0[r]; _Pragma("unroll") for(int r=0;r<16;++r)sacc+=pB1[r]; l_reg+=sacc;
    pw0=(u32x4){PKW(pB0,0),PKW(pB0,2),PKW(pB0,4),PKW(pB0,6)};pw1=(u32x4){PKW(pB0,8),PKW(pB0,10),PKW(pB0,12),PKW(pB0,14)};pw2=(u32x4){PKW(pB1,0),PKW(pB1,2),PKW(pB1,4),PKW(pB1,6)};pw3=(u32x4){PKW(pB1,8),PKW(pB1,10),PKW(pB1,12),PKW(pB1,14)};
    SBAR(); pv(o,vb0+sl_cur,PAF(0),PAF(1),PAF(2),PAF(3)); }
  #undef PKW
  #undef PAF
  #undef VFR
  #undef PIN
  #undef MX3
  #undef GAPA
  #undef GAPB
  #undef EX
  #undef VRD
  #undef KRD
  #undef STEP
  #undef ENDW
  {auto rr=__builtin_amdgcn_permlane32_swap(__float_as_uint(l_reg),__float_as_uint(l_reg),false,false);l_reg=__uint_as_float(rr[0])+__uint_as_float(rr[1]);}
  if(hi==0)wsf[32+r32]=l_reg;asm volatile("s_waitcnt lgkmcnt(0)":::"memory");
  float rli[16];
  #pragma unroll
  for(int r=0;r<16;++r)rli[r]=__builtin_amdgcn_rcpf(wsf[32+crow(r,hi)]);
  bf16*Ow=O+(rowbase+q0+wid*QBLK)*OP;
  { bf16*stg=(bf16*)(shm+LDS_OST)+wid*2048;
    #pragma unroll
    for(int r=0;r<16;++r){const int orow=crow(r,hi);
      #pragma unroll
      for(int d0=0;d0<2;++d0)stg[orow*64+d0*32+r32]=__float2bfloat16(o[d0][r]*rli[r]);}
    asm volatile("s_waitcnt lgkmcnt(0)":::"memory");
    #pragma unroll
    for(int i=0;i<4;++i){const int row=i*8+(lane>>3),ch=lane&7; const u32x4 v=*(const u32x4*)(stg+row*64+ch*8); ATTN_STORE16(Ow+(long)row*OP+ch*8,v);} }
  asm volatile("s_waitcnt lgkmcnt(0)\n\ts_barrier":::"memory");
  #undef DMA_K
  #undef DMA_V
  #undef CMASK
  #undef ROWMASK
  #undef NEARB
  #undef START
  #undef RESC
  #undef ROT
}
template<int THRL,int QP,int KP,int VP,int OP> __device__ __forceinline__ void attn_unit128(int b,int qb,const bf16*Q,const bf16*__restrict__ K,const bf16*__restrict__ V,bf16*O,char*shm,const float*btab,int wave_s,bf16*O1T,int fin,float lam,const float*subg){
  constexpr int L_K=0,L_V=3*SLOTB,L_WS=L_V+3*2*SLOTB,L_OST=L_WS+NW*64*4,L_TBL=110592;
  int tid_=wave_s*64+fresh_lane(); asm volatile("":"+v"(tid_));
  const int tid=tid_,lane=tid&63,r32=lane&31,hi=lane>>5; const int wid=wave_s;
  const long rowbase=(long)b*SEQ; const int q0=qb*QB;
  const bf16*Qw=Q+(rowbase+q0+wid*QBLK)*QP;
  const bf16*Kh=K+rowbase*KP,*Vh=V+rowbase*VP;
  const unsigned lds0=(unsigned)(uintptr_t)shm;
  float*wsf=(float*)(shm+L_WS)+wid*64;
  const bf16*ksrc=Kh+(long)lane*KP+wid*8;
  const bf16*vsrc=Vh+(long)(16*(wid&3)+(lane>>2))*VP+(wid>>2)*32+(lane&3)*8;
  const unsigned kdst=lds0+L_K+wid*1024, vdst=lds0+L_V+wid*1024;
  #define DMA_K(t,slot) glds16(ksrc+(long)(t)*KVBLK*KP,(unsigned)__builtin_amdgcn_readfirstlane(kdst+(slot)))
  #define DMA_V(t,slot) do{ glds16(vsrc+(long)(t)*KVBLK*VP,(unsigned)__builtin_amdgcn_readfirstlane(vdst+2*(slot))); glds16(vsrc+64+(long)(t)*KVBLK*VP,(unsigned)__builtin_amdgcn_readfirstlane(vdst+2*(slot)+8192)); }while(0)
  const int vb0=(int)(lds0+L_V)+((lane>>4)&1)*32+(lane&3)*8+(4*hi+((lane&15)>>2))*64;
  const char*Kbase=shm+L_K; bf16x8 kf[8];
  const lds_cptr shm3=(lds_cptr)shm; const lds_cptr kp0=shm3+L_K+hi*1024+r32*16; const lds_cptr vp0=shm3+L_V+((lane>>4)&1)*32+(lane&3)*8+(4*hi+((lane&15)>>2))*64;
  const int NT=(q0+QB)/KVBLK;
  DMA_K(0,0);DMA_V(0,0);DMA_K(1,SLOTB);
  bf16x8 qr[4];
  #pragma unroll
  for(int d0=0;d0<4;++d0)qr[d0]=*reinterpret_cast<const bf16x8*>(&Qw[(long)r32*QP+d0*16+hi*8]);
  const float B31=__builtin_bit_cast(float,__builtin_amdgcn_readfirstlane(__builtin_bit_cast(int,btab[TBLW-1])));
  { __attribute__((address_space(3))) float* tw=(__attribute__((address_space(3))) float*)(shm3+L_TBL); if(tid<TBLW)tw[tid]=btab[tid]-B31; }
  const __attribute__((address_space(3))) float* tbl=(const __attribute__((address_space(3))) float*)(shm3+L_TBL);
  const int qrel=wid*QBLK+r32;
  float mhat=0.f,l_reg=0.f;f32x16 o[4];o[0]=f32x16{};o[1]=f32x16{};o[2]=f32x16{};o[3]=f32x16{};
  #define ROWMASK(P0,P1,t) do{}while(0)
  #define NEARB(P0,P1,t) do{ const int tb_=(t)-(NT-6); if(tb_>=0){ const int base_=qrel+128-64*tb_-4*hi; \
      _Pragma("unroll") for(int r=0;r<16;++r){ const int d0_=base_-((r&3)+8*(r>>2)), d1_=d0_-32; \
        P0[r]=(d0_>=0)?P0[r]+tbl[d0_<0?0:d0_]:-INFINITY; P1[r]=(d1_>=0)?P1[r]+tbl[d1_<0?0:d1_]:-INFINITY; } } }while(0)
  #define CMASK(P0,P1,t) do{ if((t)<NT-4){ROWMASK(P0,P1,t);} NEARB(P0,P1,t); }while(0)
  bool resc=false;
  #define START(P0,P1) do{ const float rm=rowmax(P0,P1); resc=false; \
    { const float dl=__builtin_fmaxf(rm,0.f); mhat=fadd_s(mhat,dl); \
      _Pragma("unroll") for(int r=0;r<16;++r){P0[r]=fsub_s(P0[r],dl);P1[r]=fsub_s(P1[r],dl);} \
      } \
    _Pragma("unroll") for(int r=0;r<16;++r)P0[r]=__builtin_amdgcn_exp2f(P0[r]); }while(0)
  #define RESC() do{ if(resc){ asm volatile("s_waitcnt lgkmcnt(0)":::"memory"); \
      _Pragma("unroll") for(int d_=0;d_<4;++d_) _Pragma("unroll") for(int r=0;r<16;++r)o[d_][r]*=wsf[crow(r,hi)]; } }while(0)
  f32x16 pA0,pA1,pB0,pB1;
  int sl_prev=0,sl_cur=0,sl_next=SLOTB;
  #define ROT() do{sl_prev=sl_cur;sl_cur=sl_next;sl_next=(sl_next==(NSLOT-1)*SLOTB)?0:sl_next+SLOTB;}while(0)
  DMA_K(2,2*SLOTB);
  WAIT_BAR(4);
  qkt(pA0,pA1,Kbase,qr,f32x16{},r32,hi);asm volatile("s_nop 15\n\ts_nop 7":"+v"(pA0),"+v"(pA1));CMASK(pA0,pA1,0);
  START(pA0,pA1);
  _Pragma("unroll") for(int r=0;r<16;++r)pA1[r]=__builtin_amdgcn_exp2f(pA1[r]);
  WAIT_BAR(0);
  DMA_K(3,0);DMA_V(1,SLOTB);
  ROT();
  kload8(kf,kp0+sl_cur);
  WAIT_BAR(3);
  s16x4 vlo[8],vhi[8]; u32x4 pw0,pw1,pw2,pw3;
  #define PKW(P,B) cvtpk_s(P[B],P[B+1])
  #define PAF(k) __builtin_bit_cast(bf16x8,pw##k)
  #define VFR(i) (bf16x8){vlo[i][0],vlo[i][1],vlo[i][2],vlo[i][3],vhi[i][0],vhi[i][1],vhi[i][2],vhi[i][3]}
  #define PIN(x) asm volatile("":"+v"(x))
  #define MX3(a,b,c) __builtin_fmaxf(__builtin_fmaxf((a),(b)),(c))
  #define GAPA(MF,A0,A1,A2,A3,W0,W1,PW) do{ MF; sacc+=A0; sacc+=A1; sacc+=A2; sacc+=A3; PIN(sacc); W0; W1; PIN(PW); SBAR(); }while(0)
  #define EX(v) __builtin_amdgcn_exp2f(v)
  #define GAPB(MF,X,B) do{ MF; X[B]=EX(X[B]-mhat); X[B+1]=EX(X[B+1]-mhat); X[B+2]=EX(X[B+2]-mhat); X[B+3]=EX(X[B+3]-mhat); PIN(X); SBAR(); }while(0)
  #define VRD(i) do{ vlo[i]=vtr(vp_+(((i)>>2)*4096+((i)&3)*1024)); vhi[i]=vtr(vp_+(((i)>>2)*4096+((i)&3)*1024+512)); }while(0)
  #define VRD2(i) do{ vlo[i]=vtr(vp_+(8192+((i)>>2)*4096+((i)&3)*1024)); vhi[i]=vtr(vp_+(8192+((i)>>2)*4096+((i)&3)*1024+512)); SBAR(); }while(0)
  #define WFR(i) VFR(i)
  #define MFB2(D,K_,I) do{ o[D]=__builtin_amdgcn_mfma_f32_32x32x16_bf16(PAF(K_),WFR(I),o[D],0,0,0); SBAR(); }while(0)
  #define KRD(G,j) do{ if(G){ kload2(kf,kp0+sl_next,j); SBAR(); } }while(0)
  #define STEP(C0,C1,P0,P1,t,GK,GV,GL) do{ SBAR(); \
    const lds_cptr vp_=vp0+2*sl_prev; \
    VRD(0); SBAR(); float sacc=(P0[0]+P0[1]); \
    GAPA(C0=__builtin_amdgcn_mfma_f32_32x32x16_bf16(kf[0],qr[0],f32x16{},0,0,0), P0[2],P0[3],P0[4],P0[5],     pw0[0]=PKW(P0,0), pw0[1]=PKW(P0,2), pw0); \
    VRD(4); SBAR(); GAPA(C1=__builtin_amdgcn_mfma_f32_32x32x16_bf16(kf[1],qr[0],f32x16{},0,0,0), P0[6],P0[7],P0[8],P0[9],     pw0[2]=PKW(P0,4), pw0[3]=PKW(P0,6), pw0); \
    VRD(1); SBAR(); GAPA(C0=__builtin_amdgcn_mfma_f32_32x32x16_bf16(kf[2],qr[1],C0,0,0,0),   P0[10],P0[11],P0[12],P0[13], pw1[0]=PKW(P0,8), pw1[1]=PKW(P0,10), pw1); \
    VRD(5); SBAR(); GAPA(C1=__builtin_amdgcn_mfma_f32_32x32x16_bf16(kf[3],qr[1],C1,0,0,0),   P0[14],P0[15],P1[0],P1[1],   pw1[2]=PKW(P0,12),pw1[3]=PKW(P0,14), pw1); \
    VRD(2); SBAR(); GAPA(C0=__builtin_amdgcn_mfma_f32_32x32x16_bf16(kf[4],qr[2],C0,0,0,0),   P1[2],P1[3],P1[4],P1[5],     pw2[0]=PKW(P1,0), pw2[1]=PKW(P1,2), pw2); \
    VRD(6); SBAR(); GAPA(C1=__builtin_amdgcn_mfma_f32_32x32x16_bf16(kf[5],qr[2],C1,0,0,0),   P1[6],P1[7],P1[8],P1[9],     pw2[2]=PKW(P1,4), pw2[3]=PKW(P1,6), pw2); \
    VRD(3); SBAR(); GAPA(C0=__builtin_amdgcn_mfma_f32_32x32x16_bf16(kf[6],qr[3],C0,0,0,0),   P1[10],P1[11],P1[12],P1[13], pw3[0]=PKW(P1,8), pw3[1]=PKW(P1,10), pw3); \
    VRD(7); SBAR(); GAPA(C1=__builtin_amdgcn_mfma_f32_32x32x16_bf16(kf[7],qr[3],C1,0,0,0),   P1[14],P1[15],0.f,0.f,       pw3[2]=PKW(P1,12),pw3[3]=PKW(P1,14), pw3); \
    l_reg+=sacc; \
    if(GK){DMA_K((t)+3,sl_cur);} if(GV){DMA_V((t)+1,sl_next);} \
    CMASK(C0,C1,t); \
    { float a=MX3(C0[0],C0[1],C1[0]),b=MX3(C0[2],C0[3],C1[1]); a=MX3(a,C1[2],C1[3]); \
      _Pragma("unroll") for(int r=4;r<16;r+=4){a=MX3(a,C0[r],C0[r+1]);b=MX3(b,C0[r+2],C0[r+3]);a=MX3(a,C1[r],C1[r+1]);b=MX3(b,C1[r+2],C1[r+3]);} \
      float rm=__builtin_fmaxf(a,b); { auto rr=__builtin_amdgcn_permlane32_swap(__float_as_uint(rm),__float_as_uint(rm),false,false); rm=__builtin_fmaxf(__uint_as_float(rr[0]),__uint_as_float(rr[1])); } \
      resc=false; \
      if(__builtin_expect(__any(rm-mhat>(float)THRL),0)){ const float dl=__builtin_fmaxf(rm-mhat,0.f); mhat+=dl; \
        const float f=__builtin_amdgcn_exp2f(-dl); l_reg*=f; { const int l_=fresh_lane(); if(l_<32)((__attribute__((address_space(3))) float*)(shm3+L_WS+wid*256))[l_]=f; } resc=true; } } \
    SBAR(); \
    GAPB(o[0]=__builtin_amdgcn_mfma_f32_32x32x16_bf16(PAF(0),VFR(0),o[0],0,0,0), C0,0); VRD2(0); \
    GAPB(o[1]=__builtin_amdgcn_mfma_f32_32x32x16_bf16(PAF(0),VFR(4),o[1],0,0,0), C0,4); VRD2(4); \
    KRD(GL,0); GAPB(o[0]=__builtin_amdgcn_mfma_f32_32x32x16_bf16(PAF(1),VFR(1),o[0],0,0,0), C0,8); VRD2(1); \
    KRD(GL,1); GAPB(o[1]=__builtin_amdgcn_mfma_f32_32x32x16_bf16(PAF(1),VFR(5),o[1],0,0,0), C0,12); VRD2(5); \
    KRD(GL,2); GAPB(o[0]=__builtin_amdgcn_mfma_f32_32x32x16_bf16(PAF(2),VFR(2),o[0],0,0,0), C1,0); VRD2(2); \
    KRD(GL,3); GAPB(o[1]=__builtin_amdgcn_mfma_f32_32x32x16_bf16(PAF(2),VFR(6),o[1],0,0,0), C1,4); VRD2(6); \
    GAPB(o[0]=__builtin_amdgcn_mfma_f32_32x32x16_bf16(PAF(3),VFR(3),o[0],0,0,0), C1,8); VRD2(3); \
    GAPB(o[1]=__builtin_amdgcn_mfma_f32_32x32x16_bf16(PAF(3),VFR(7),o[1],0,0,0), C1,12); VRD2(7); \
    MFB2(2,0,0); MFB2(3,0,4); MFB2(2,1,1); MFB2(3,1,5); MFB2(2,2,2); MFB2(3,2,6); MFB2(2,3,3); MFB2(3,3,7); \
    }while(0)
  int t=1;
  #undef CMASK
  #define CMASK(P0,P1,t) ROWMASK(P0,P1,t)
  for(;t+7<NT;t+=2){
    STEP(pB0,pB1,pA0,pA1,t,true,true,true);     WAIT_BAR(3); RESC(); ROT();
    STEP(pA0,pA1,pB0,pB1,t+1,true,true,true);   WAIT_BAR(3); RESC(); ROT();
  }
  #undef CMASK
  #define CMASK(P0,P1,t) do{ if((t)<NT-4){ROWMASK(P0,P1,t);} NEARB(P0,P1,t); }while(0)
  #define ENDW(tt) do{ if((tt)+3<NT){WAIT_BAR(3);} else if((tt)+2<NT){WAIT_BAR(2);} else {WAIT_BAR(0);} }while(0)
  for(;t+1<NT;t+=2){
    STEP(pB0,pB1,pA0,pA1,t,(t+3<NT),(t+1<NT),(t+1<NT));       ENDW(t);   RESC(); ROT();
    STEP(pA0,pA1,pB0,pB1,t+1,(t+4<NT),(t+2<NT),(t+2<NT));     ENDW(t+1); RESC(); ROT();
  }
  STEP(pB0,pB1,pA0,pA1,NT-1,false,false,false); RESC();
  { float sacc=pB0[0]+pB0[1]; _Pragma("unroll") for(int r=2;r<16;++r)sacc+=pB0[r]; _Pragma("unroll") for(int r=0;r<16;++r)sacc+=pB1[r]; l_reg+=sacc;
    pw0=(u32x4){PKW(pB0,0),PKW(pB0,2),PKW(pB0,4),PKW(pB0,6)};pw1=(u32x4){PKW(pB0,8),PKW(pB0,10),PKW(pB0,12),PKW(pB0,14)};pw2=(u32x4){PKW(pB1,0),PKW(pB1,2),PKW(pB1,4),PKW(pB1,6)};pw3=(u32x4){PKW(pB1,8),PKW(pB1,10),PKW(pB1,12),PKW(pB1,14)};
    SBAR(); { const int l2=fresh_lane(); const int vbe=(int)(lds0+L_V)+((l2>>4)&1)*32+(l2&3)*8+(4*(l2>>5)+((l2&15)>>2))*64;
      pv(o,vbe+2*sl_cur,PAF(0),PAF(1),PAF(2),PAF(3)); pv(o+2,vbe+2*sl_cur+8192,PAF(0),PAF(1),PAF(2),PAF(3)); } }
  #undef PKW
  #undef PAF
  #undef VFR
  #undef PIN
  #undef MX3
  #undef GAPA
  #undef GAPB
  #undef EX
  #undef VRD
  #undef KRD
  #undef VRD2
  #undef WFR
  #undef MFB2
  #undef STEP
  #undef ENDW
  {auto rr=__builtin_amdgcn_permlane32_swap(__float_as_uint(l_reg),__float_as_uint(l_reg),false,false);l_reg=__uint_as_float(rr[0])+__uint_as_float(rr[1]);}
  const int l3=fresh_lane(), r32e=l3&31, hie=l3>>5; __attribute__((address_space(3))) float* wse=(__attribute__((address_space(3))) float*)(shm3+L_WS+wid*256);
  if(hie==0)wse[32+r32e]=l_reg;asm volatile("s_waitcnt lgkmcnt(0)":::"memory");
  float rli[16];
  #pragma unroll
  for(int r=0;r<16;++r)rli[r]=__builtin_amdgcn_rcpf(wse[32+crow(r,hie)]);
  bf16*Ow=O+(rowbase+q0+wid*QBLK)*OP;
  bf16*O1w=O1T+(rowbase+q0+wid*QBLK)*OP;
  { bf16*stg=(bf16*)(shm+L_OST)+wid*2048;
    u32x4 keep[2][4]; const int le=fresh_lane(), erow=le>>3, ech=le&7;
    #pragma unroll
    for(int hf=0;hf<2;++hf){
      #pragma unroll
      for(int r=0;r<16;++r){const int orow=crow(r,hie);
        #pragma unroll
        for(int d0=0;d0<2;++d0)stg[orow*64+d0*32+r32e]=__float2bfloat16(o[2*hf+d0][r]*rli[r]);}
      asm volatile("s_waitcnt lgkmcnt(0)":::"memory");
      #pragma unroll
      for(int i=0;i<4;++i){const int row=i*8+erow,ch=ech; const u32x4 v=*(const u32x4*)(stg+row*64+ch*8); keep[hf][i]=v; if(!fin)ATTN_STORE16(O1w+(long)row*OP+hf*64+ch*8,v);}
      asm volatile("s_waitcnt lgkmcnt(0)":::"memory"); }
    if(fin){
      const int ch=ech; float sg[16]; asm volatile("":"+s"(subg));
      #pragma unroll
      for(int j=0;j<8;++j){sg[j]=subg[ch*8+j]*0.8f;sg[8+j]=subg[64+ch*8+j]*0.8f;}
      #pragma unroll
      for(int i=0;i<4;++i){const int row=i*8+erow; float d[16]; float ss=0.f;
        #pragma unroll
        for(int hf=0;hf<2;++hf){ const u32x4 a=*(const u32x4*)(O1w+(long)row*OP+hf*64+ch*8); const u32x4 c=keep[hf][i];
          #pragma unroll
          for(int w=0;w<4;++w){ const float a0=__builtin_bit_cast(float,a[w]<<16),a1=__builtin_bit_cast(float,a[w]&0xffff0000u),c0=__builtin_bit_cast(float,c[w]<<16),c1=__builtin_bit_cast(float,c[w]&0xffff0000u);
            d[hf*8+2*w]=a0-lam*c0; d[hf*8+2*w+1]=a1-lam*c1; } }
        #pragma unroll
        for(int j=0;j<16;++j)ss+=d[j]*d[j];
        ss+=__builtin_bit_cast(float,__builtin_amdgcn_update_dpp(0,__builtin_bit_cast(int,ss),0xB1,0xf,0xf,true));
        ss+=__builtin_bit_cast(float,__builtin_amdgcn_update_dpp(0,__builtin_bit_cast(int,ss),0x4E,0xf,0xf,true));
        ss+=__builtin_bit_cast(float,__builtin_amdgcn_update_dpp(0,__builtin_bit_cast(int,ss),0x141,0xf,0xf,true));
        const float rs=1.f/sqrtf(ss*(1.f/128.f)+1e-5f);
        #pragma unroll
        for(int hf=0;hf<2;++hf){ u32x4 w; w[0]=cvtpk_s(d[hf*8]*rs*sg[hf*8],d[hf*8+1]*rs*sg[hf*8+1]); w[1]=cvtpk_s(d[hf*8+2]*rs*sg[hf*8+2],d[hf*8+3]*rs*sg[hf*8+3]);
          w[2]=cvtpk_s(d[hf*8+4]*rs*sg[hf*8+4],d[hf*8+5]*rs*sg[hf*8+5]); w[3]=cvtpk_s(d[hf*8+6]*rs*sg[hf*8+6],d[hf*8+7]*rs*sg[hf*8+7]);
          ATTN_STORE16(Ow+(long)row*OP+hf*64+ch*8,w); } } } }
  asm volatile("s_waitcnt lgkmcnt(0)\n\ts_barrier":::"memory");
  #undef DMA_K
  #undef DMA_V
  #undef CMASK
  #undef ROWMASK
  #undef NEARB
  #undef START
  #undef RESC
  #undef ROT
}

constexpr int ATTN_LDS_BYTES=TBL_OFF+2048+1024;
#undef SBAR
#undef WAIT_BAR
}
#define PG8_SP2 true
#define PG8_ALIGN true
typedef unsigned short bf16_t;
typedef float f32x4 __attribute__((ext_vector_type(4)));
typedef unsigned u32x4 __attribute__((ext_vector_type(4)));
typedef unsigned u32x2 __attribute__((ext_vector_type(2)));
#define LAS __attribute__((address_space(3)))
constexpr int BATCH = 2, SEQ = 16384, DM = 1024, MTOK = BATCH * SEQ, NPROJ = 4608, NGATE = 2048, NIN = 6656, FF = 4096, NMEM = 256;
constexpr float LN_EPS = 1e-5f, ALPHA = 1.189207115002721f, LOG2E = 1.4426950408889634f;
constexpr float C2 = 0.125f * LOG2E, XC2 = 0.0625f * LOG2E, LAM_INIT = 0.2f;
constexpr size_t MiB = 1u << 20;
constexpr size_t WS_TAB = 1 * MiB, WS_KMEAN = WS_TAB + 65536;
constexpr size_t WS_WIN = 2 * MiB, WS_WBD = 15 * MiB, WS_WBM = 17 * MiB, WS_WOUT = 18 * MiB, WS_WQ = 20 * MiB, WS_WK = 22 * MiB, WS_WV = 24 * MiB, WS_WO = 26 * MiB, WS_W1 = 28 * MiB, WS_W2 = 36 * MiB;
constexpr size_t WS_MEMB = 44 * MiB, WS_KX = 45 * MiB, WS_VXT = 46 * MiB;
constexpr size_t WS_HB = 48 * MiB, WS_X1 = 112 * MiB, WS_QD = 176 * MiB, WS_KD = 240 * MiB, WS_VD = 304 * MiB, WS_MQ = 368 * MiB, WS_MK = 400 * MiB, WS_MV = 432 * MiB, WS_END = 464 * MiB;
constexpr int NWAVES = 8, LDS_BYTES = 147456;
constexpr int BIASW = 384;

__device__ __forceinline__ unsigned f2bf(float f) { unsigned u = __builtin_bit_cast(unsigned, f); return (u + 0x7fffu + ((u >> 16) & 1u)) >> 16; }
__device__ __forceinline__ unsigned pk2(float lo, float hi) { unsigned r; asm("v_cvt_pk_bf16_f32 %0, %1, %2" : "=v"(r) : "v"(lo), "v"(hi)); return r; }
__device__ __forceinline__ float bflo(unsigned u) { return __builtin_bit_cast(float, u << 16); }
__device__ __forceinline__ float bfhi(unsigned u) { return __builtin_bit_cast(float, u & 0xffff0000u); }
__device__ __forceinline__ float wave_sum(float v) {
#pragma unroll
    for (int o = 1; o < 64; o <<= 1) v += __shfl_xor(v, o);
    return v;
}
__device__ __forceinline__ void store8bf(bf16_t* p, const float (&v)[8]) { u32x4 w; w.x = pk2(v[0], v[1]); w.y = pk2(v[2], v[3]); w.z = pk2(v[4], v[5]); w.w = pk2(v[6], v[7]); *(u32x4*)p = w; }
__device__ __forceinline__ void load8bf(const bf16_t* p, float (&v)[8]) { const u32x4 w = *(const u32x4*)p; v[0] = bflo(w.x); v[1] = bfhi(w.x); v[2] = bflo(w.y); v[3] = bfhi(w.y); v[4] = bflo(w.z); v[5] = bfhi(w.z); v[6] = bflo(w.w); v[7] = bfhi(w.w); }

enum { EK_PROJ = 0, EK_GATE, EK_T, EK_MIX, EK_RES, EK_SCALE, EK_RELU2, EK_F32 };
template <int KIND> struct Epi {
    static constexpr bool PERM = true, AFTER_DRAIN = false;
    int ldc; float scale; bf16_t* o; float* of; const bf16_t* gsrc; const float* aux; unsigned char* ws;
    __device__ __forceinline__ void put8(int row, int col0, float (&v)[8]) const {
        switch (KIND) {
        case EK_PROJ: {
            const int t = col0 >> 8; size_t base; int pitch, c; float sc = 1.f;
            if (t < 4) { base = WS_QD; pitch = 1024; c = col0; sc = C2; } else if (t < 8) { base = WS_KD; pitch = 1024; c = col0 - 1024; } else if (t < 12) { base = WS_VD; pitch = 1024; c = col0 - 2048; }
            else if (t < 14) { base = WS_MQ; pitch = 512; c = col0 - 3072; sc = C2; } else if (t < 16) { base = WS_MK; pitch = 512; c = col0 - 3584; } else { base = WS_MV; pitch = 512; c = col0 - 4096; }
#pragma unroll
            for (int i = 0; i < 8; ++i) v[i] *= sc;
            store8bf((bf16_t*)(ws + base) + (size_t)row * pitch + c, v); } break;
        case EK_GATE: {
            const f32x4 b0 = *(const f32x4*)(aux + col0), b1 = *(const f32x4*)(aux + col0 + 4);
#pragma unroll
            for (int i = 0; i < 8; ++i) { const float z = v[i] + (i < 4 ? b0[i] : b1[i - 4]); v[i] = 1.f / (1.f + __expf(-z)); }
            store8bf(o + (size_t)row * NGATE + col0, v); } break;
        case EK_T: {
            float g[8]; load8bf(gsrc + (size_t)row * NGATE + col0, g);
#pragma unroll
            for (int i = 0; i < 8; ++i) v[i] *= g[i];
            store8bf(o + (size_t)row * DM + col0, v); } break;
        case EK_MIX: {
            { float g[8]; load8bf(gsrc + (size_t)row * NGATE + DM + col0, g);
#pragma unroll
              for (int i = 0; i < 8; ++i) v[i] *= g[i]; }
            asm volatile("" : "+v"(v[0]), "+v"(v[1]), "+v"(v[2]), "+v"(v[3]), "+v"(v[4]), "+v"(v[5]), "+v"(v[6]), "+v"(v[7]) :: "memory");
            { float t[8]; load8bf(o + (size_t)row * DM + col0, t);
#pragma unroll
              for (int i = 0; i < 8; ++i) v[i] += t[i]; }
            store8bf(o + (size_t)row * DM + col0, v); } break;
        case EK_RES: {
            float* p = of + (size_t)row * DM + col0;
            { const f32x4 a = *(const f32x4*)p; *(f32x4*)p = (f32x4){ALPHA * a[0] + v[0], ALPHA * a[1] + v[1], ALPHA * a[2] + v[2], ALPHA * a[3] + v[3]}; }
            asm volatile("" ::: "memory");
            { const f32x4 b = *(const f32x4*)(p + 4); *(f32x4*)(p + 4) = (f32x4){ALPHA * b[0] + v[4], ALPHA * b[1] + v[5], ALPHA * b[2] + v[6], ALPHA * b[3] + v[7]}; } } break;
        case EK_SCALE: {
#pragma unroll
            for (int i = 0; i < 8; ++i) v[i] *= scale;
            store8bf(o + (size_t)row * ldc + col0, v); } break;
        case EK_RELU2: {
#pragma unroll
            for (int i = 0; i < 8; ++i) { const float r = fmaxf(v[i], 0.f); v[i] = r * r; }
            store8bf(o + (size_t)row * ldc + col0, v); } break;
        default: {
            float* p = of + (size_t)row * ldc + col0;
            *(f32x4*)p = (f32x4){v[0], v[1], v[2], v[3]}; *(f32x4*)(p + 4) = (f32x4){v[4], v[5], v[6], v[7]}; } break;
        }
    }
    __device__ __forceinline__ void operator()(const pg8::f32x4 (&acc)[2][2][4][2], const pg8::Unit& u, int wr, int wc, int fr, int fq) const {
#pragma unroll
        for (int ai = 0; ai < 2; ++ai)
#pragma unroll
            for (int m = 0; m < 4; ++m)
#pragma unroll
                for (int bj = 0; bj < 2; ++bj) {
                    const int row = u.pm * 256 + ai * 128 + wr * 64 + m * 16 + fr, col0 = u.pn * 256 + bj * 128 + wc * 32 + 8 * fq;
                    float v[8] = {acc[ai][bj][m][0][0], acc[ai][bj][m][0][1], acc[ai][bj][m][0][2], acc[ai][bj][m][0][3], acc[ai][bj][m][1][0], acc[ai][bj][m][1][1], acc[ai][bj][m][1][2], acc[ai][bj][m][1][3]};
                    put8(row, col0, v); asm volatile("" ::: "memory");
                }
    }
};
struct Ctx { int tid, lane, wave, vcu, G; LAS unsigned char* lds; };

__device__ __forceinline__ void transpose_item(const float* W, int K, int N, bf16_t* WT, LAS float* scr, int item, int lane) {
    const int nblk = N / 32, kb = item / nblk, nb = item % nblk, k0 = 64 * kb, n0 = 32 * nb;
#pragma unroll 8
    for (int i = 0; i < 32; ++i) { const int kk = 2 * i + (lane >> 5); scr[kk * 33 + (lane & 31)] = W[(size_t)(k0 + kk) * N + n0 + (lane & 31)]; }
    asm volatile("s_waitcnt lgkmcnt(0)" ::: "memory");
    const int c = lane & 7;
#pragma unroll
    for (int j = 0; j < 4; ++j) { const int n = (lane >> 3) + 8 * j; const LAS float* s = scr + (8 * c) * 33 + n;
        u32x4 o; o.x = pk2(s[0 * 33], s[1 * 33]); o.y = pk2(s[2 * 33], s[3 * 33]); o.z = pk2(s[4 * 33], s[5 * 33]); o.w = pk2(s[6 * 33], s[7 * 33]);
        *(u32x4*)(WT + (size_t)(n0 + n) * K + k0 + 8 * c) = o; }
    asm volatile("s_waitcnt lgkmcnt(0)" ::: "memory");
}
__device__ __forceinline__ void ln_row(const float* src, const float* g, const float* bb, float* dstf, bf16_t* dstb, int lane) {
    f32x4 v[4]; float s = 0.f;
#pragma unroll
    for (int j = 0; j < 4; ++j) { v[j] = *((const f32x4*)src + lane + 64 * j); s += (v[j][0] + v[j][1]) + (v[j][2] + v[j][3]); }
    const float mean = wave_sum(s) * (1.f / DM); float s2 = 0.f;
#pragma unroll
    for (int j = 0; j < 4; ++j) { v[j] = v[j] - mean; s2 += (v[j][0] * v[j][0] + v[j][1] * v[j][1]) + (v[j][2] * v[j][2] + v[j][3] * v[j][3]); }
    const float rstd = 1.f / sqrtf(wave_sum(s2) * (1.f / DM) + LN_EPS);
#pragma unroll
    for (int j = 0; j < 4; ++j) { const f32x4 gg = *((const f32x4*)g + lane + 64 * j), b4 = *((const f32x4*)bb + lane + 64 * j); const f32x4 o = v[j] * rstd * gg + b4;
        if (dstf) *((f32x4*)dstf + lane + 64 * j) = o;
        if (dstb) { u32x2 w; w.x = pk2(o[0], o[1]); w.y = pk2(o[2], o[3]); *((u32x2*)dstb + lane + 64 * j) = w; } }
}
__device__ __forceinline__ int rel_bucket(int n) {
    if (n < 16) return n;
    int l = 16 + (int)(logf((float)n / 16.f) / logf(8.f) * 16.f);
    return l < 31 ? l : 31;
}

__device__ __forceinline__ void naive_diff(const Ctx& C, unsigned char* ws) {
    const bf16_t* Qd = (const bf16_t*)(ws + WS_QD); const bf16_t* Kd = (const bf16_t*)(ws + WS_KD); const bf16_t* Vd = (const bf16_t*)(ws + WS_VD);
    bf16_t* O2 = (bf16_t*)(ws + WS_HB); const float* BIAS2 = (const float*)(ws + WS_TAB);
    const int gw = C.vcu * NWAVES + C.wave, NGW = C.G * NWAVES;
    for (int wi0 = gw; wi0 < 16384; wi0 += NGW) {
        const int wi1 = __builtin_amdgcn_readfirstlane(wi0); const int vh = wi1 & 1, wi = wi1 >> 1;
        const int pass = wi1 / NGW; const int qblk = (pass & 1) ? 255 - (wi & 255) : (wi & 255); const int hm = (wi >> 8) & 15, b = wi >> 12, h = hm >> 1;
        const int q = qblk * 64 + C.lane; const size_t rb = (size_t)b * SEQ;
        float qf[64];
        { const u32x4* qp = (const u32x4*)(Qd + (rb + q) * 1024 + hm * 64);
#pragma unroll
          for (int i = 0; i < 8; ++i) { const u32x4 w = qp[i]; qf[8 * i] = bflo(w.x); qf[8 * i + 1] = bfhi(w.x); qf[8 * i + 2] = bflo(w.y); qf[8 * i + 3] = bfhi(w.y); qf[8 * i + 4] = bflo(w.z); qf[8 * i + 5] = bfhi(w.z); qf[8 * i + 6] = bflo(w.w); qf[8 * i + 7] = bfhi(w.w); } }
        float o[64];
#pragma unroll
        for (int j = 0; j < 64; ++j) o[j] = 0.f;
        float mx = -1e30f, l = 0.f; const float* bt = BIAS2 + h * BIASW; const float b31 = bt[BIASW - 1];
        const int kend = qblk * 64 + 63;
        for (int k = 0; k <= kend; ++k) {
            const unsigned* kr = (const unsigned*)(Kd + (rb + k) * 1024 + hm * 64);
            float s0 = 0.f, s1 = 0.f;
#pragma unroll
            for (int j = 0; j < 32; ++j) { const unsigned u = kr[j]; s0 += qf[2 * j] * bflo(u); s1 += qf[2 * j + 1] * bfhi(u); }
            const int d = q - k; float s = s0 + s1;
            s += (d < BIASW) ? bt[d < 0 ? 0 : d] : b31;
            if (d >= 0) {
                if (s > mx) { const float f = __builtin_amdgcn_exp2f(mx - s); l *= f;
#pragma unroll
                    for (int j = 0; j < 64; ++j) o[j] *= f;
                    mx = s; }
                const float p = __builtin_amdgcn_exp2f(s - mx); l += p;
                const unsigned* vr = (const unsigned*)(Vd + (rb + k) * 1024 + h * 128 + vh * 64);
#pragma unroll
                for (int j = 0; j < 32; ++j) { const unsigned u = vr[j]; o[2 * j] += p * bflo(u); o[2 * j + 1] += p * bfhi(u); }
            }
        }
        const float rl = 1.f / l; unsigned* op = (unsigned*)(O2 + (rb + q) * 2048 + hm * 128 + vh * 64);
#pragma unroll
        for (int j = 0; j < 32; ++j) op[j] = pk2(o[2 * j] * rl, o[2 * j + 1] * rl);
    }
}
__device__ __forceinline__ void naive_moba(const Ctx& C, unsigned char* ws) {
    bf16_t* Mq = (bf16_t*)(ws + WS_MQ); const bf16_t* Mk = (const bf16_t*)(ws + WS_MK); const bf16_t* Mv = (const bf16_t*)(ws + WS_MV);
    const bf16_t* KM = (const bf16_t*)(ws + WS_KMEAN); const float* BIAS2 = (const float*)(ws + WS_TAB);
    const int gw = C.vcu * NWAVES + C.wave, NGW = C.G * NWAVES;
    for (int wi0 = gw; wi0 < 4096; wi0 += NGW) {
        const int wi = __builtin_amdgcn_readfirstlane(wi0);
        const int qblk = wi & 255, h = (wi >> 8) & 7, b = wi >> 11, cur = qblk >> 2;
        const int q = qblk * 64 + C.lane; const size_t rb = (size_t)b * SEQ;
        float qf[64];
        { const u32x4* qp = (const u32x4*)(Mq + (rb + q) * 512 + h * 64);
#pragma unroll
          for (int i = 0; i < 8; ++i) { const u32x4 w = qp[i]; qf[8 * i] = bflo(w.x); qf[8 * i + 1] = bfhi(w.x); qf[8 * i + 2] = bflo(w.y); qf[8 * i + 3] = bfhi(w.y); qf[8 * i + 4] = bflo(w.z); qf[8 * i + 5] = bfhi(w.z); qf[8 * i + 6] = bflo(w.w); qf[8 * i + 7] = bfhi(w.w); } }
        float v0 = -INFINITY, v1 = -INFINITY, v2 = -INFINITY; int i0 = -1, i1 = -1, i2 = -1;
        for (int n = 0; n < cur; ++n) {
            const unsigned* kr = (const unsigned*)(KM + ((size_t)(b * 8 + h) * 64 + n) * 64);
            float g0 = 0.f, g1 = 0.f;
#pragma unroll
            for (int j = 0; j < 32; ++j) { const unsigned u = kr[j]; g0 += qf[2 * j] * bflo(u); g1 += qf[2 * j + 1] * bfhi(u); }
            const float g = g0 + g1;
            if (g > v0) { v2 = v1; i2 = i1; v1 = v0; i1 = i0; v0 = g; i0 = n; } else if (g > v1) { v2 = v1; i2 = i1; v1 = g; i1 = n; } else if (g > v2) { v2 = g; i2 = n; }
        }
        float o[64];
#pragma unroll
        for (int j = 0; j < 64; ++j) o[j] = 0.f;
        float mx = -1e30f, l = 0.f; const float* bt = BIAS2 + (8 + h) * BIASW; const float b31 = bt[BIASW - 1];
        for (int slot = 0; slot < 3; ++slot) {
            const int blk = slot == 0 ? i0 : (slot == 1 ? i1 : i2);
            if (slot < cur) {
                for (int kk = 0; kk < 256; ++kk) {
                    const int kpos = blk * 256 + kk;
                    const unsigned* kr = (const unsigned*)(Mk + (rb + kpos) * 512 + h * 64);
                    float s0 = 0.f, s1 = 0.f;
#pragma unroll
                    for (int j = 0; j < 32; ++j) { const unsigned u = kr[j]; s0 += qf[2 * j] * bflo(u); s1 += qf[2 * j + 1] * bfhi(u); }
                    const int d = q - kpos; float s = s0 + s1; s += (d < BIASW) ? bt[d] : b31;
                    if (s > mx) { const float f = __builtin_amdgcn_exp2f(mx - s); l *= f;
#pragma unroll
                        for (int j = 0; j < 64; ++j) o[j] *= f;
                        mx = s; }
                    const float p = __builtin_amdgcn_exp2f(s - mx); l += p;
                    const unsigned* vr = (const unsigned*)(Mv + (rb + kpos) * 512 + h * 64);
#pragma unroll
                    for (int j = 0; j < 32; ++j) { const unsigned u = vr[j]; o[2 * j] += p * bflo(u); o[2 * j + 1] += p * bfhi(u); }
                }
            }
        }
        const int kend = qblk * 64 + 63;
        for (int kpos = cur * 256; kpos <= kend; ++kpos) {
            const unsigned* kr = (const unsigned*)(Mk + (rb + kpos) * 512 + h * 64);
            float s0 = 0.f, s1 = 0.f;
#pragma unroll
            for (int j = 0; j < 32; ++j) { const unsigned u = kr[j]; s0 += qf[2 * j] * bflo(u); s1 += qf[2 * j + 1] * bfhi(u); }
            const int d = q - kpos; float s = s0 + s1; s += bt[d < 0 ? 0 : d];
            if (d >= 0) {
                if (s > mx) { const float f = __builtin_amdgcn_exp2f(mx - s); l *= f;
#pragma unroll
                    for (int j = 0; j < 64; ++j) o[j] *= f;
                    mx = s; }
                const float p = __builtin_amdgcn_exp2f(s - mx); l += p;
                const unsigned* vr = (const unsigned*)(Mv + (rb + kpos) * 512 + h * 64);
#pragma unroll
                for (int j = 0; j < 32; ++j) { const unsigned u = vr[j]; o[2 * j] += p * bflo(u); o[2 * j + 1] += p * bfhi(u); }
            }
        }
        const float rl = 1.f / l; unsigned* op = (unsigned*)(Mq + (rb + q) * 512 + h * 64);
#pragma unroll
        for (int j = 0; j < 32; ++j) op[j] = pk2(o[2 * j] * rl, o[2 * j + 1] * rl);
    }
}
#ifndef NAIVE_ATTN
#define NAIVE_ATTN 0
#endif
#ifndef DUPMASK
#define DUPMASK 0
#endif
#ifndef EXTRA_BARS
#define EXTRA_BARS 0
#endif
struct Args { const float* in[27]; float* out; unsigned char* ws; int lo, hi; };
enum { IN_X = 0, IN_MEM, IN_LNG, IN_LNB, IN_REL, IN_WIN, IN_BG, IN_LQ1, IN_LK1, IN_LQ2, IN_LK2, IN_SUBG, IN_WBD, IN_WBM, IN_WOUT, IN_LN1G, IN_LN1B, IN_WQ, IN_WK, IN_WV, IN_WO, IN_LN2G, IN_LN2B, IN_W1, IN_W2, IN_LN3G, IN_LN3B };
constexpr int NSTEPS = 20;
__host__ __device__ constexpr bool sync_after(int s) { return !(s == 1 || s == 2 || s == 7); }

__device__ __forceinline__ void grid_bar(unsigned* ctr, unsigned target, int wave_s) {
    asm volatile("s_waitcnt vmcnt(0)" ::: "memory");
    __syncthreads();
    if (wave_s == 0 && fresh_lane() == 0) {
        __builtin_amdgcn_fence(__ATOMIC_RELEASE, "agent");
        asm volatile("s_waitcnt vmcnt(0)" ::: "memory");
        __hip_atomic_fetch_add(ctr, 1u, __ATOMIC_RELAXED, __HIP_MEMORY_SCOPE_AGENT);
        unsigned spins = 0;
        while (__hip_atomic_load(ctr, __ATOMIC_RELAXED, __HIP_MEMORY_SCOPE_AGENT) < target) { __builtin_amdgcn_s_sleep(1); if (++spins > (1u << 27)) break; }
        __builtin_amdgcn_fence(__ATOMIC_ACQUIRE, "agent");
        asm volatile("s_waitcnt vmcnt(0)" ::: "memory");
    }
    __syncthreads();
}
__global__ void __launch_bounds__(NWAVES * 64, 2) fwd(Args args) {
    extern __shared__ __attribute__((aligned(16))) unsigned char lds_raw[];
    cg::grid_group grid = cg::this_grid();
    Ctx C; C.lds = (LAS unsigned char*)lds_raw; const int wave_s = __builtin_amdgcn_readfirstlane((int)threadIdx.x >> 6);
#define RECTX() do { int t_ = wave_s * 64 + fresh_lane(); asm volatile("" : "+v"(t_)); C.tid = t_; C.lane = t_ & 63; C.wave = __builtin_amdgcn_readfirstlane(t_ >> 6); gw = C.vcu * NWAVES + C.wave; } while (0)
    C.G = gridDim.x; { const int bx = blockIdx.x; C.vcu = (C.G % 8 == 0) ? (bx % 8) * (C.G / 8) + bx / 8 : bx; }
    unsigned char* ws = args.ws; float* out = args.out;
    int gw = 0; const int NGW = C.G * NWAVES;
    bf16_t* HB = (bf16_t*)(ws + WS_HB);
    const int lo = args.lo, hi = args.hi; unsigned nbar = 0;
#define IN(k) (lo <= (k) && (k) < hi)
#define SEAM(k) do { if ((k) == 4 && hi - lo > 1) { for (int xb_ = 0; xb_ < EXTRA_BARS; ++xb_) { ++nbar; grid_bar((unsigned*)ws, nbar * (unsigned)C.G, wave_s); } } if ((k) + 1 < hi) { if (!sync_after(k)) __syncthreads(); else if ((k) == 0) grid.sync(); else { ++nbar; grid_bar((unsigned*)ws, nbar * (unsigned)C.G, wave_s); } } } while (0)
#define GEMM(k, KK, LDA, LDB, APN, BPN, BPM, DIV, Ap, Bp, MM, NN, KIND, SETUP) if (IN(k)) { pg8::GemmT<KK, LDA, LDB, APN, BPN, BPM, DIV> g{Ap, Bp, MM, NN}; Epi<KIND> E{}; E.ws = ws; SETUP; \
        pg8::StaticOrder S; S.init(MM, NN, C.G, (int)blockIdx.x); _Pragma("unroll 1") for (int rep_ = 0; rep_ < 1 + ((DUPMASK >> (k)) & 1); ++rep_) { pg8::gemm_phase<Epi<KIND>, pg8::StaticOrder, ((k) != 14) && PG8_ALIGN, PG8_SP2>(C.lds, g, S, E, wave_s); __syncthreads(); } SEAM(k); }
    if (IN(0)) { RECTX();
            LAS float* scr = (LAS float*)(C.lds + C.wave * 16384);
            const float* Ws[10] = {args.in[IN_WIN], args.in[IN_WBD], args.in[IN_WBM], args.in[IN_WOUT], args.in[IN_WQ], args.in[IN_WK], args.in[IN_WV], args.in[IN_WO], args.in[IN_W1], args.in[IN_W2]};
            const int Ks[10] = {1024, 1024, 512, 1024, 1024, 1024, 1024, 1024, 1024, 4096}, Ns[10] = {NIN, 1024, 1024, 1024, 1024, 1024, 1024, 1024, 4096, 1024};
            const size_t Os[10] = {WS_WIN, WS_WBD, WS_WBM, WS_WOUT, WS_WQ, WS_WK, WS_WV, WS_WO, WS_W1, WS_W2};
#pragma unroll
            for (int w = 0; w < 10; ++w) { const int nit = (Ks[w] / 64) * (Ns[w] / 32);
                for (int it = gw; it < nit; it += NGW) transpose_item(Ws[w], Ks[w], Ns[w], (bf16_t*)(ws + Os[w]), scr, it, C.lane); }
            for (int m = gw; m < MTOK; m += NGW) ln_row(args.in[IN_X] + (size_t)m * DM, args.in[IN_LNG], args.in[IN_LNB], out + (size_t)m * DM, HB + (size_t)m * DM, C.lane);
            { const float* mem = args.in[IN_MEM]; unsigned* mb = (unsigned*)(ws + WS_MEMB);
              for (int i = blockIdx.x * 512 + C.tid; i < BATCH * NMEM * DM / 2; i += C.G * 512) mb[i] = pk2(mem[2 * i], mem[2 * i + 1]); }
            { float* tb = (float*)(ws + WS_TAB); const float* rel = args.in[IN_REL];
              for (int i = blockIdx.x * 512 + C.tid; i < 16 * BIASW; i += C.G * 512) { const int h = i / BIASW, d = i % BIASW; tb[i] = rel[rel_bucket(d) * 16 + h] * LOG2E; } }
            SEAM(0); }
    GEMM(1, 1024, 1024, 1024, 0, 256 * 1024, 0, 1, HB, (const bf16_t*)(ws + WS_WIN), MTOK, NPROJ, EK_PROJ, (void)0)
    GEMM(2, 1024, 1024, 1024, 0, 256 * 1024, 0, 1, (const bf16_t*)(ws + WS_MEMB), (const bf16_t*)(ws + WS_WK), BATCH * NMEM, 1024, EK_SCALE, (E.scale = 1.f, E.o = (bf16_t*)(ws + WS_KX), E.ldc = 1024))
    GEMM(3, 1024, 1024, 1024, 0, 256 * 1024, 0, 1, (const bf16_t*)(ws + WS_WV), (const bf16_t*)(ws + WS_MEMB), 1024, BATCH * NMEM, EK_SCALE, (E.scale = 1.f, E.o = (bf16_t*)(ws + WS_VXT), E.ldc = 1024))
    if (IN(4)) { RECTX();
            { const bf16_t* Mk = (const bf16_t*)(ws + WS_MK); bf16_t* KM = (bf16_t*)(ws + WS_KMEAN);
              for (int blk = gw; blk < BATCH * 8 * 64; blk += NGW) { const int n = blk & 63, h = (blk >> 6) & 7, b = blk >> 9;
                  const bf16_t* p = Mk + ((size_t)b * SEQ + n * 256 + (C.lane >> 3)) * 512 + h * 64 + (C.lane & 7) * 8; float a[8];
#pragma unroll
                  for (int j = 0; j < 8; ++j) a[j] = 0.f;
#pragma unroll 8
                  for (int r = 0; r < 32; ++r) { float v[8]; load8bf(p + (size_t)r * 8 * 512, v);
#pragma unroll
                      for (int j = 0; j < 8; ++j) a[j] += v[j]; }
#pragma unroll
                  for (int j = 0; j < 8; ++j) { a[j] += __shfl_xor(a[j], 8); a[j] += __shfl_xor(a[j], 16); a[j] += __shfl_xor(a[j], 32); a[j] *= (1.f / 256.f); }
                  if (C.lane < 8) store8bf(KM + (size_t)blk * 64 + C.lane * 8, a); } }
            __syncthreads();
#if NAIVE_ATTN
            naive_diff(C, ws);
#else
            { const attn_body::bf16* Qd = (const attn_body::bf16*)(ws + WS_QD); const attn_body::bf16* Kd = (const attn_body::bf16*)(ws + WS_KD); const attn_body::bf16* Vd = (const attn_body::bf16*)(ws + WS_VD);
              const float* BIAS2 = (const float*)(ws + WS_TAB);
              const float lam_v = expf(wave_sum(args.in[IN_LQ1][C.lane] * args.in[IN_LK1][C.lane])) - expf(wave_sum(args.in[IN_LQ2][C.lane] * args.in[IN_LK2][C.lane])) + LAM_INIT;
              const float lam = __builtin_bit_cast(float, __builtin_amdgcn_readfirstlane(__builtin_bit_cast(int, lam_v)));
              attn_body::bf16* O1T = (attn_body::bf16*)(ws + WS_X1); attn_body::bf16* OD = (attn_body::bf16*)(ws + WS_QD);
              for (int i = 0;; ++i) {
                  int combo, qb;
                  if (C.G == 256) { if (i >= 4) break; const int s = C.vcu & 15; combo = C.vcu >> 4; qb = (i == 0) ? s : (i == 1) ? 31 - s : (i == 2) ? 32 + s : 63 - s; }
                  else { const int u = C.vcu + i * C.G; if (u >= 1024) break; combo = u >> 6; qb = u & 63; }
                  const int b = combo >> 3, h = combo & 7;
#pragma unroll 1
                  for (int m = 0; m < 2; ++m)
                      attn_body::attn_unit128<8, 1024, 1024, 1024, 1024>(b, qb, Qd + (2 * h + m) * 64, Kd + (2 * h + m) * 64, Vd + h * 128, OD + h * 128, (char*)lds_raw, BIAS2 + h * BIASW, wave_s, O1T + h * 128, m, lam, args.in[IN_SUBG]);
              } }
#endif
            SEAM(4); }
    if (IN(5)) { RECTX();
            __syncthreads();
#if NAIVE_ATTN
            naive_moba(C, ws);
#else
            { attn_body::bf16* Mq = (attn_body::bf16*)(ws + WS_MQ); const attn_body::bf16* Mk = (const attn_body::bf16*)(ws + WS_MK); const attn_body::bf16* Mv = (const attn_body::bf16*)(ws + WS_MV);
              const attn_body::bf16* KM = (const attn_body::bf16*)(ws + WS_KMEAN); const float* BIAS2 = (const float*)(ws + WS_TAB);
              for (int i = 0;; ++i) {
                  int combo, qb;
                  if (C.G == 256) { if (i >= 4) break; const int s = C.vcu & 15; combo = C.vcu >> 4; qb = (i == 0) ? s : (i == 1) ? 31 - s : (i == 2) ? 32 + s : 63 - s; }
                  else { const int u = C.vcu + i * C.G; if (u >= 1024) break; combo = u >> 6; qb = u & 63; }
                  const int b = combo >> 3, h = combo & 7;
                  attn_body::attn_unit<8, 1, 512, 512, 512, 512>(b, qb, Mq + h * 64, Mk + h * 64, Mv + h * 64, Mq + h * 64, (char*)lds_raw, BIAS2 + (8 + h) * BIASW, KM + (size_t)(b * 8 + h) * 4096, wave_s);
              } }
#endif
            SEAM(5); }
    GEMM(6, 1024, 1024, 1024, 0, 256 * 1024, 0, 1, HB, (const bf16_t*)(ws + WS_WIN) + (size_t)NPROJ * 1024, MTOK, NGATE, EK_GATE, (E.o = (bf16_t*)(ws + WS_KD), E.aux = args.in[IN_BG]))
    GEMM(7, 1024, 1024, 1024, 0, 256 * 1024, 0, 1, (const bf16_t*)(ws + WS_QD), (const bf16_t*)(ws + WS_WBD), MTOK, 1024, EK_T, (E.o = (bf16_t*)(ws + WS_X1), E.gsrc = (const bf16_t*)(ws + WS_KD)))
    GEMM(8, 512, 512, 512, 0, 256 * 512, 0, 1, (const bf16_t*)(ws + WS_MQ), (const bf16_t*)(ws + WS_WBM), MTOK, 1024, EK_MIX, (E.o = (bf16_t*)(ws + WS_X1), E.gsrc = (const bf16_t*)(ws + WS_KD)))
    GEMM(9, 1024, 1024, 1024, 0, 256 * 1024, 0, 1, (const bf16_t*)(ws + WS_X1), (const bf16_t*)(ws + WS_WOUT), MTOK, 1024, EK_RES, (E.of = out))
    if (IN(10)) { RECTX(); for (int m = gw; m < MTOK; m += NGW) ln_row(out + (size_t)m * DM, args.in[IN_LN1G], args.in[IN_LN1B], out + (size_t)m * DM, HB + (size_t)m * DM, C.lane); SEAM(10); }
    GEMM(11, 1024, 1024, 1024, 0, 256 * 1024, 0, 1, HB, (const bf16_t*)(ws + WS_WQ), MTOK, 1024, EK_SCALE, (E.scale = XC2, E.o = (bf16_t*)(ws + WS_QD), E.ldc = 1024))
    GEMM(12, 256, 1024, 1024, 256, 256, 256 * 1024, 64, (const bf16_t*)(ws + WS_QD), (const bf16_t*)(ws + WS_KX), MTOK, 1024, EK_F32, (E.of = (float*)(ws + WS_HB), E.ldc = 1024))
    if (IN(13)) { RECTX();
            const float* SF = (const float*)(ws + WS_HB); bf16_t* P = (bf16_t*)(ws + WS_KD);
            for (int m = gw; m < MTOK; m += NGW) {
                f32x4 v[4];
#pragma unroll
                for (int j = 0; j < 4; ++j) v[j] = *((const f32x4*)(SF + (size_t)m * DM) + C.lane + 64 * j);
#pragma unroll
                for (int j = 0; j < 4; ++j) { float mx = fmaxf(fmaxf(v[j][0], v[j][1]), fmaxf(v[j][2], v[j][3]));
#pragma unroll
                    for (int o = 1; o < 64; o <<= 1) mx = fmaxf(mx, __shfl_xor(mx, o));
                    f32x4 e; e[0] = __builtin_amdgcn_exp2f(v[j][0] - mx); e[1] = __builtin_amdgcn_exp2f(v[j][1] - mx); e[2] = __builtin_amdgcn_exp2f(v[j][2] - mx); e[3] = __builtin_amdgcn_exp2f(v[j][3] - mx);
                    const float rl = 1.f / wave_sum((e[0] + e[1]) + (e[2] + e[3]));
                    u32x2 w; w.x = pk2(e[0] * rl, e[1] * rl); w.y = pk2(e[2] * rl, e[3] * rl); *((u32x2*)(P + (size_t)m * DM) + C.lane + 64 * j) = w; }
            }
            SEAM(13); }
    GEMM(14, 256, 1024, 1024, 256, 256 * 1024, 256, 64, (const bf16_t*)(ws + WS_KD), (const bf16_t*)(ws + WS_VXT), MTOK, 1024, EK_SCALE, (E.scale = 1.f, E.o = (bf16_t*)(ws + WS_VD), E.ldc = 1024))
    GEMM(15, 1024, 1024, 1024, 0, 256 * 1024, 0, 1, (const bf16_t*)(ws + WS_VD), (const bf16_t*)(ws + WS_WO), MTOK, 1024, EK_RES, (E.of = out))
    if (IN(16)) { RECTX(); for (int m = gw; m < MTOK; m += NGW) ln_row(out + (size_t)m * DM, args.in[IN_LN2G], args.in[IN_LN2B], out + (size_t)m * DM, HB + (size_t)m * DM, C.lane); SEAM(16); }
    GEMM(17, 1024, 1024, 1024, 0, 256 * 1024, 0, 1, HB, (const bf16_t*)(ws + WS_W1), MTOK, FF, EK_RELU2, (E.o = (bf16_t*)(ws + WS_X1), E.ldc = FF))
    GEMM(18, FF, FF, FF, 0, 256 * FF, 0, 1, (const bf16_t*)(ws + WS_X1), (const bf16_t*)(ws + WS_W2), MTOK, 1024, EK_RES, (E.of = out))
    if (IN(19)) { RECTX(); for (int m = gw; m < MTOK; m += NGW) ln_row(out + (size_t)m * DM, args.in[IN_LN3G], args.in[IN_LN3B], out + (size_t)m * DM, nullptr, C.lane); }
}

#ifndef NAIVE_ATTN
#define NAIVE_ATTN 0
#endif
#ifndef N_LAUNCH_MODE
#define N_LAUNCH_MODE 1
#endif
extern "C" void kernel_launch(void* const* d_in, const int* in_sizes, int n_in, void* d_out, int out_size, void* d_ws, size_t ws_size, hipStream_t stream) {
    static int grid = 0;
    if (grid == 0) {
        if (n_in != 27 || out_size != MTOK * DM || ws_size < WS_END) { fprintf(stderr, "kernel_launch: unexpected shapes (n_in %d out %d ws %zu)\n", n_in, out_size, ws_size); grid = -1; return; }
        int dev = 0, cus = 0, per_cu = 0;
        hipGetDevice(&dev); hipDeviceGetAttribute(&cus, hipDeviceAttributeMultiprocessorCount, dev);
        if (hipFuncSetAttribute((const void*)fwd, hipFuncAttributeMaxDynamicSharedMemorySize, LDS_BYTES) != hipSuccess) { fprintf(stderr, "kernel_launch: hipFuncSetAttribute failed\n"); grid = -1; return; }
        hipOccupancyMaxActiveBlocksPerMultiprocessor(&per_cu, (const void*)fwd, NWAVES * 64, LDS_BYTES);
        (void)hipGetLastError();
        if (per_cu < 1) fprintf(stderr, "kernel_launch: occupancy query says %d blocks/CU\n", per_cu);
        grid = cus > 0 ? cus : 256;
    }
    if (grid < 0) return;
    (void)hipMemsetAsync(d_ws, 0, 256, stream);
    Args a{};
    for (int i = 0; i < 27; ++i) a.in[i] = (const float*)d_in[i];
    a.out = (float*)d_out; a.ws = (unsigned char*)d_ws;
#if N_LAUNCH_MODE == 1
    a.lo = 0; a.hi = NSTEPS;
    void* kargs[] = {&a};
    hipError_t e = hipLaunchCooperativeKernel((const void*)fwd, dim3(grid), dim3(NWAVES * 64), kargs, LDS_BYTES, stream);
    if (e != hipSuccess) fprintf(stderr, "cooperative launch failed: %s (grid %d)\n", hipGetErrorString(e), grid);
#else
    int lo = 0;
    for (int s = 0; s < NSTEPS; ++s) if (sync_after(s) || s == NSTEPS - 1) { a.lo = lo; a.hi = s + 1; hipLaunchKernelGGL(fwd, dim3(grid), dim3(NWAVES * 64), LDS_BYTES, stream, a); lo = s + 1; }
#endif
}
```

```cpp
#include <hip/hip_runtime.h>
#include <hip/hip_cooperative_groups.h>
#include <hip/hip_bf16.h>
#include <cstdio>
#include <cstdint>
#include <cmath>
namespace cg = cooperative_groups;
__device__ __forceinline__ int fresh_lane() { int l; asm volatile("v_mbcnt_lo_u32_b32 %0, -1, 0\n\tv_mbcnt_hi_u32_b32 %0, -1, %0" : "=v"(l)); return l; }
namespace pg8 {
#define PG8_LAS __attribute__((address_space(3)))
typedef unsigned short bf16_t;
typedef short bf16x8 __attribute__((ext_vector_type(8)));
typedef float f32x4 __attribute__((ext_vector_type(4)));
typedef unsigned u32x4 __attribute__((ext_vector_type(4)));
constexpr int BM = 256, BK = 64, HALF = 128, HTB = HALF * BK * 2  , STAGE_BYTES = 8 * HTB, NXCD = 8, WGM = 8;

__host__ __device__ __forceinline__ int lds_byte(int r, int c) { const int st = (r >> 4) * 2 + (c >> 5), rr = r & 15, cc = c & 31, ob = rr * 64 + cc * 2; return st * 1024 + (ob ^ (((ob >> 9) & 1) << 5)); }
__host__ __device__ __forceinline__ void stage_rc(int b, int& R, int& C) { const int st = b / 1024, sb = b % 1024, swz = sb ^ (((sb >> 9) & 1) << 5); R = (st >> 1) * 16 + swz / 64; C = (st & 1) * 32 + (swz % 64) / 2; }
__host__ __device__ __forceinline__ int perm32(int rho) { const int n = rho >> 4, i = rho & 15; return 8 * (i >> 2) + 4 * n + (i & 3); }

struct Unit { int pm, pn; };
template <int K_, int LDA, int LDB, int APN, int BPN, int BPM, int DIV> struct GemmT { const bf16_t* A; const bf16_t* Bt; int M, N;
    static constexpr int K = K_, lda = LDA, ldb = LDB;
    __device__ __forceinline__ const char* abase(const Unit& u) const { return (const char*)(A + (size_t)u.pm * BM * LDA + (size_t)u.pn * APN); }
    __device__ __forceinline__ const char* bbase(const Unit& u) const { return (const char*)(Bt + (size_t)u.pn * BPN + (size_t)(u.pm / DIV) * BPM); } };

struct StaticOrder {
    int nM, nN, nwg, G, c;
    __host__ __device__ void init(int M, int N, int G_, int c_) { nM = M / BM; nN = N / BM; nwg = nM * nN; G = G_; c = c_; }
    __host__ __device__ bool next(int i, Unit& u) const {
        const long L = (long)i * G + c; if (L >= nwg) return false;
        int wgid = (int)L; { const int q = nwg / NXCD, r = nwg % NXCD, xcd = wgid % NXCD, off = wgid / NXCD; wgid = (xcd < r ? xcd * (q + 1) : r * (q + 1) + (xcd - r) * q) + off; }
        const int nig = WGM * nN, gid = wgid / nig, fm = gid * WGM, gsz = (nM - fm) < WGM ? (nM - fm) : WGM;
        u.pm = fm + ((wgid % nig) % gsz); u.pn = (wgid % nig) / gsz; return true;
    }
    __device__ __forceinline__ void a_ready(const Unit&) const {}
    __device__ __forceinline__ void done(const Unit&) const {}
};

__device__ __forceinline__ unsigned cvt_pk_bf16(float lo, float hi) { unsigned r; asm volatile("v_cvt_pk_bf16_f32 %0, %1, %2" : "=v"(r) : "v"(lo), "v"(hi)); return r; }
template <class Epi, class Sched, bool ALIGN_EPI, bool SP2, class GT>
__device__ __forceinline__ void gemm_phase(PG8_LAS unsigned char* lds, const GT g, const Sched& S, const Epi& E, int wave_s) {
    int tid_ = wave_s * 64 + fresh_lane(); asm volatile("" : "+v"(tid_));
    const int tid = tid_, wid = __builtin_amdgcn_readfirstlane(tid >> 6), lane = tid & 63, wr = wid >> 2, wc = wid & 3, fr = lane & 15, fq = lane >> 4;
    const int K = g.K, nt = K / BK;
    unsigned voffA[2], voffB[2];
#pragma unroll
    for (int i = 0; i < 2; ++i) { int R, C; stage_rc(tid * 16 + i * 8192, R, C); const int Rb = Epi::PERM ? ((R & ~31) + perm32(R & 31)) : R;
        voffA[i] = (unsigned)(R * g.lda + C) * 2u; voffB[i] = (unsigned)(Rb * g.ldb + C) * 2u; }
    const size_t kstep = (size_t)(BK * 2);
    const size_t hA = (size_t)HALF * g.lda * 2, hB = (size_t)HALF * g.ldb * 2;
    const unsigned ldsw = (unsigned)wid * 1024u;
    const int aoff = lds_byte(wr * 64 + fr, fq * 8), boff = lds_byte(wc * 32 + fr, fq * 8);
#define PG8_SA(b, h) (((b) * 2 + (h)) * HTB)
#define PG8_SB(b, h) ((4 + (b) * 2 + (h)) * HTB)
#define PG8_STAGE(bufoff, gbase, voff) do { _Pragma("unroll") for (int _i = 0; _i < 2; ++_i) \
        __builtin_amdgcn_global_load_lds((const unsigned*)((const char*)(gbase) + (voff)[_i]), (PG8_LAS unsigned*)(lds + (bufoff) + ldsw + _i * 8192), 16, 0, 0); } while (0)
#define PG8_LDA(dst, b, h) do { _Pragma("unroll") for (int m = 0; m < 4; ++m) _Pragma("unroll") for (int k = 0; k < 2; ++k) dst[m][k] = *(const PG8_LAS bf16x8*)(lds + PG8_SA(b, h) + aoff + m * 2048 + k * 1024); } while (0)
#define PG8_LDB(dst, b, h) do { _Pragma("unroll") for (int n = 0; n < 2; ++n) _Pragma("unroll") for (int k = 0; k < 2; ++k) dst[n][k] = *(const PG8_LAS bf16x8*)(lds + PG8_SB(b, h) + boff + n * 2048 + k * 1024); } while (0)
#define PG8_MMA(ai, bj, At, Bt) do { __builtin_amdgcn_s_setprio(1); _Pragma("unroll") for (int m = 0; m < 4; ++m) _Pragma("unroll") for (int n = 0; n < 2; ++n) _Pragma("unroll") for (int k = 0; k < 2; ++k) \
        acc[ai][bj][m][n] = __builtin_amdgcn_mfma_f32_16x16x32_bf16(Bt[n][k], At[m][k], acc[ai][bj][m][n], 0, 0, 0); __builtin_amdgcn_s_setprio(0); } while (0)
#define PG8_WAIT_V(n) asm volatile("s_waitcnt vmcnt(" #n ")" ::: "memory")
#define PG8_WAIT_L(n) asm volatile("s_waitcnt lgkmcnt(" #n ")" ::: "memory")
#define PG8_BAR __builtin_amdgcn_s_barrier()
#define PG8_SCHED __builtin_amdgcn_sched_barrier(0)
    Unit cur, nxt; int ui = 0;
    if (!S.next(0, cur)) return;
    f32x4 acc[2][2][4][2];
#pragma unroll
    for (int a = 0; a < 2; ++a)
#pragma unroll
        for (int b = 0; b < 2; ++b)
#pragma unroll
            for (int m = 0; m < 4; ++m)
#pragma unroll
                for (int n = 0; n < 2; ++n) acc[a][b][m][n] = (f32x4){0.f, 0.f, 0.f, 0.f};
    bf16x8 At[4][2], B0[2][2], B1[2][2];
    const char* cA = g.abase(cur); const char* cB = g.bbase(cur);
    S.a_ready(cur);
    if constexpr (SP2) {
        PG8_STAGE(PG8_SB(0, 0), cB, voffB); PG8_STAGE(PG8_SB(0, 1), cB + hB, voffB); PG8_STAGE(PG8_SA(0, 0), cA, voffA); PG8_STAGE(PG8_SA(0, 1), cA + hA, voffA);
        if (wr == 1) PG8_BAR;
        PG8_WAIT_V(2); PG8_BAR;
        PG8_STAGE(PG8_SB(1, 0), cB + kstep, voffB); PG8_STAGE(PG8_SA(1, 0), cA + kstep, voffA); PG8_STAGE(PG8_SB(1, 1), cB + hB + kstep, voffB);
        PG8_WAIT_V(6); PG8_BAR;
    } else {
        PG8_STAGE(PG8_SB(0, 0), cB, voffB); PG8_STAGE(PG8_SA(0, 0), cA, voffA); PG8_STAGE(PG8_SB(0, 1), cB + hB, voffB); PG8_STAGE(PG8_SA(0, 1), cA + hA, voffA);
        if (wr == 1) PG8_BAR;
        PG8_WAIT_V(4); PG8_BAR;
        PG8_STAGE(PG8_SB(1, 0), cB + kstep, voffB); PG8_STAGE(PG8_SA(1, 0), cA + kstep, voffA); PG8_STAGE(PG8_SB(1, 1), cB + hB + kstep, voffB);
        PG8_WAIT_V(6); PG8_BAR;
    }
    for (;;) {
        const bool has_next = S.next(ui + 1, nxt);
        const char* nA = has_next ? g.abase(nxt) : cA; const char* nB = has_next ? g.bbase(nxt) : cB;
        for (int t = 0; t < nt; t += 2) {
            const bool last = (t == nt - 2);
            const char* a1 = cA + (size_t)(t + 1) * kstep;
            const char* a2 = last ? nA : cA + (size_t)(t + 2) * kstep; const char* b2 = last ? nB : cB + (size_t)(t + 2) * kstep;
            const char* a3 = a2 + kstep; const char* b3 = b2 + kstep;
            if (last && has_next) S.a_ready(nxt);
            if constexpr (SP2) {
            PG8_LDB(B0, 0, 0); PG8_LDB(B1, 0, 1); PG8_SCHED; PG8_LDA(At, 0, 0); PG8_STAGE(PG8_SA(1, 1), a1 + hA, voffA);
            PG8_WAIT_V(8); PG8_WAIT_L(0); PG8_BAR; PG8_MMA(0, 0, At, B0); PG8_MMA(0, 1, At, B1); PG8_BAR; PG8_SCHED;
            PG8_LDA(At, 0, 1); PG8_STAGE(PG8_SB(0, 0), b2, voffB); PG8_STAGE(PG8_SB(0, 1), b2 + hB, voffB); PG8_STAGE(PG8_SA(0, 0), a2, voffA);
            PG8_WAIT_V(8); PG8_WAIT_L(0); PG8_BAR; PG8_MMA(1, 0, At, B0); PG8_MMA(1, 1, At, B1); PG8_BAR; PG8_SCHED;
            PG8_LDB(B0, 1, 0); PG8_LDB(B1, 1, 1); PG8_SCHED; PG8_LDA(At, 1, 0); PG8_STAGE(PG8_SA(0, 1), a2 + hA, voffA);
            PG8_WAIT_V(8); PG8_WAIT_L(0); PG8_BAR; PG8_MMA(0, 0, At, B0); PG8_MMA(0, 1, At, B1); PG8_BAR; PG8_SCHED;
            PG8_LDA(At, 1, 1); PG8_STAGE(PG8_SB(1, 0), b3, voffB); PG8_STAGE(PG8_SB(1, 1), b3 + hB, voffB); PG8_STAGE(PG8_SA(1, 0), a3, voffA);
            PG8_WAIT_V(8); PG8_WAIT_L(0); PG8_BAR; PG8_MMA(1, 0, At, B0); PG8_MMA(1, 1, At, B1); PG8_BAR; PG8_SCHED;
            } else {
            PG8_LDB(B0, 0, 0); PG8_SCHED; PG8_LDA(At, 0, 0); PG8_STAGE(PG8_SA(1, 1), a1 + hA, voffA);
            PG8_WAIT_L(8); PG8_BAR; PG8_WAIT_L(0); PG8_MMA(0, 0, At, B0); PG8_BAR; PG8_SCHED;
            PG8_LDB(B1, 0, 1); PG8_STAGE(PG8_SB(0, 0), b2, voffB);
            PG8_BAR; PG8_WAIT_L(0); PG8_MMA(0, 1, At, B1); PG8_BAR;
            PG8_LDA(At, 0, 1); PG8_STAGE(PG8_SA(0, 0), a2, voffA);
            PG8_BAR; PG8_WAIT_L(0); PG8_MMA(1, 0, At, B0); PG8_BAR; PG8_SCHED;
            PG8_STAGE(PG8_SB(0, 1), b2 + hB, voffB);
            PG8_WAIT_V(6); PG8_BAR; PG8_MMA(1, 1, At, B1); PG8_BAR;
            PG8_LDB(B0, 1, 0); PG8_SCHED; PG8_LDA(At, 1, 0); PG8_STAGE(PG8_SA(0, 1), a2 + hA, voffA);
            PG8_WAIT_L(8); PG8_BAR; PG8_WAIT_L(0); PG8_MMA(0, 0, At, B0); PG8_BAR; PG8_SCHED;
            PG8_LDB(B1, 1, 1); PG8_STAGE(PG8_SB(1, 0), b3, voffB);
            PG8_BAR; PG8_WAIT_L(0); PG8_MMA(0, 1, At, B1); PG8_BAR;
            PG8_LDA(At, 1, 1); PG8_STAGE(PG8_SA(1, 0), a3, voffA);
            PG8_BAR; PG8_WAIT_L(0); PG8_MMA(1, 0, At, B0); PG8_BAR; PG8_SCHED;
            PG8_STAGE(PG8_SB(1, 1), b3 + hB, voffB);
            PG8_WAIT_V(6); PG8_BAR; PG8_MMA(1, 1, At, B1); PG8_BAR;
            }
        }
        if constexpr (ALIGN_EPI) { if (wr == 0) PG8_BAR; }
        if constexpr (!Epi::AFTER_DRAIN) { E(acc, cur, wr, wc, fr, fq); S.done(cur); }
        if (!has_next) break;
#pragma unroll
        for (int a = 0; a < 2; ++a)
#pragma unroll
            for (int b = 0; b < 2; ++b)
#pragma unroll
                for (int m = 0; m < 4; ++m)
#pragma unroll
                    for (int n = 0; n < 2; ++n) acc[a][b][m][n] = (f32x4){0.f, 0.f, 0.f, 0.f};
        cur = nxt; cA = nA; cB = nB; ++ui;
        if constexpr (ALIGN_EPI) { if (wr == 1) PG8_BAR; }
    }
    PG8_WAIT_V(0);
    if constexpr (!ALIGN_EPI) { if (wr == 0) PG8_BAR; }
    PG8_BAR;
    if constexpr (Epi::AFTER_DRAIN) { E.fused(acc, cur, wr, wc, fr, fq, lds, wid, lane); S.done(cur); }
#undef PG8_SA
#undef PG8_SB
#undef PG8_STAGE
#undef PG8_LDA
#undef PG8_LDB
#undef PG8_MMA
#undef PG8_WAIT_V
#undef PG8_WAIT_L
#undef PG8_BAR
#undef PG8_SCHED
}
}
namespace attn_body {
using bf16=__hip_bfloat16;
using bf16x8=__attribute__((ext_vector_type(8)))short;
using s16x4=__attribute__((ext_vector_type(4)))short;
using f32x16=__attribute__((ext_vector_type(16)))float;
using u32x4=__attribute__((ext_vector_type(4)))unsigned;
constexpr int SEQ=16384,D=64;
constexpr int NW=8,QBLK=32,QB=QBLK*NW,KVBLK=64,NQB=SEQ/QB;
constexpr int TBL_OFF=98304, TBLW=384;
__device__ __forceinline__ int crow(int r,int hi){return (r&3)+8*(r>>2)+4*hi;}
#define SBAR() __builtin_amdgcn_sched_barrier(0)
__device__ __forceinline__ void cmask(f32x16&p0,f32x16&p1,int jb,int qrel,int hi){
  const float NEG=-INFINITY; int kb=64*jb+4*hi;
  #pragma unroll
  for(int r=0;r<16;++r){int kv=kb+(r&3)+8*(r>>2); if(kv>qrel)p0[r]=NEG; if(kv+32>qrel)p1[r]=NEG;}
}

constexpr int NSLOT=3, SLOTB=8192;
constexpr int LDS_K=0, LDS_V=NSLOT*SLOTB, LDS_WS=2*NSLOT*SLOTB, LDS_OST=LDS_WS+NW*64*4, LDS_BYTES=LDS_OST+NW*4096;
constexpr float C2=0.125f*1.4426950408889634f;
__device__ __forceinline__ void glds16(const void*gsrc,unsigned lds_dst){unsigned keep;
  asm volatile("s_mov_b32 %0, m0\n\ts_mov_b32 m0, %2\n\ts_nop 0\n\tglobal_load_lds_dwordx4 %1, off\n\ts_mov_b32 m0, %0":"=&s"(keep):"v"(gsrc),"s"(lds_dst):"memory");}
__device__ __forceinline__ float max3f(float a,float b,float c){float r;asm("v_max3_f32 %0, %1, %2, %3":"=v"(r):"v"(a),"v"(b),"v"(c));return r;}
__device__ __forceinline__ float max2f(float a,float b){float r;asm("v_max_f32_e32 %0, %1, %2":"=v"(r):"v"(a),"v"(b));return r;}
__device__ __forceinline__ float fadd_s(float a,float b){float r;asm("v_add_f32_e32 %0, %1, %2":"=v"(r):"v"(a),"v"(b));return r;}
__device__ __forceinline__ float fsub_s(float a,float b){float r;asm("v_sub_f32_e32 %0, %1, %2":"=v"(r):"v"(a),"v"(b));return r;}
typedef float f32x2_t __attribute__((ext_vector_type(2))); typedef __bf16 bf16x2_t __attribute__((ext_vector_type(2)));
__device__ __forceinline__ unsigned cvtpk_s(float lo,float hi){f32x2_t v={lo,hi};bf16x2_t b=__builtin_convertvector(v,bf16x2_t);return __builtin_bit_cast(unsigned,b);}
#define WAIT_BAR(N) asm volatile("s_waitcnt vmcnt(" #N ") lgkmcnt(0)\n\ts_barrier":::"memory")

__device__ __forceinline__ void qkt(f32x16&p0,f32x16&p1,const char*Kslot,const bf16x8*qr,const f32x16&negm,int r32,int hi){
  const char*kb=Kslot+hi*1024+r32*16;
  #pragma unroll
  for(int d0=0;d0<4;++d0){
    const bf16x8 b0=*reinterpret_cast<const bf16x8*>(kb+d0*2048);
    const bf16x8 b1=*reinterpret_cast<const bf16x8*>(kb+d0*2048+512);
    if(d0==0){p0=__builtin_amdgcn_mfma_f32_32x32x16_bf16(b0,qr[0],negm,0,0,0);p1=__builtin_amdgcn_mfma_f32_32x32x16_bf16(b1,qr[0],negm,0,0,0);}
    else{p0=__builtin_amdgcn_mfma_f32_32x32x16_bf16(b0,qr[d0],p0,0,0,0);p1=__builtin_amdgcn_mfma_f32_32x32x16_bf16(b1,qr[d0],p1,0,0,0);}}
}
typedef __attribute__((address_space(3))) const char* lds_cptr;
typedef short v4i16_t __attribute__((ext_vector_type(4)));
__device__ __forceinline__ void kload8(bf16x8*kf,lds_cptr kp){
  kf[0]=*(const __attribute__((address_space(3))) bf16x8*)(kp);      kf[1]=*(const __attribute__((address_space(3))) bf16x8*)(kp+512);
  kf[2]=*(const __attribute__((address_space(3))) bf16x8*)(kp+2048); kf[3]=*(const __attribute__((address_space(3))) bf16x8*)(kp+2560);
  kf[4]=*(const __attribute__((address_space(3))) bf16x8*)(kp+4096); kf[5]=*(const __attribute__((address_space(3))) bf16x8*)(kp+4608);
  kf[6]=*(const __attribute__((address_space(3))) bf16x8*)(kp+6144); kf[7]=*(const __attribute__((address_space(3))) bf16x8*)(kp+6656);
}
__device__ __forceinline__ void kload2(bf16x8*kf,lds_cptr kp,int j){ kf[2*j]=*(const __attribute__((address_space(3))) bf16x8*)(kp+j*2048); kf[2*j+1]=*(const __attribute__((address_space(3))) bf16x8*)(kp+j*2048+512); }
__device__ __forceinline__ s16x4 vtr(lds_cptr p){ return __builtin_bit_cast(s16x4,__builtin_amdgcn_ds_read_tr16_b64_v4i16((__attribute__((address_space(3))) v4i16_t*)p)); }
__device__ __forceinline__ float rowmax(const f32x16&p0,const f32x16&p1){
  float a=max3f(p0[0],p0[1],p1[0]),b=max3f(p0[2],p0[3],p1[1]);a=max3f(a,p1[2],p1[3]);
  #pragma unroll
  for(int r=4;r<16;r+=4){a=max3f(a,p0[r],p0[r+1]);b=max3f(b,p0[r+2],p0[r+3]);a=max3f(a,p1[r],p1[r+1]);b=max3f(b,p1[r+2],p1[r+3]);}
  const float m=max2f(a,b);
  auto rr=__builtin_amdgcn_permlane32_swap(__float_as_uint(m),__float_as_uint(m),false,false);
  return max2f(__uint_as_float(rr[0]),__uint_as_float(rr[1]));
}
__device__ __forceinline__ void pv(f32x16*o,int vb,bf16x8 pa0,bf16x8 pa1,bf16x8 pa2,bf16x8 pa3){
  #pragma unroll
  for(int d0=0;d0<2;++d0){s16x4 lo[4],hi[4];
    #pragma unroll
    for(int ks=0;ks<4;++ks){
      asm volatile("ds_read_b64_tr_b16 %0,%1 offset:%c2":"=&v"(lo[ks]):"v"(vb),"i"(d0*4096+ks*1024):"memory");
      asm volatile("ds_read_b64_tr_b16 %0,%1 offset:%c2":"=&v"(hi[ks]):"v"(vb),"i"(d0*4096+ks*1024+512):"memory");}
    asm volatile("s_waitcnt lgkmcnt(0)":::"memory");SBAR();
    #define PK(k) (bf16x8){lo[k][0],lo[k][1],lo[k][2],lo[k][3],hi[k][0],hi[k][1],hi[k][2],hi[k][3]}
    o[d0]=__builtin_amdgcn_mfma_f32_32x32x16_bf16(pa0,PK(0),o[d0],0,0,0);
    o[d0]=__builtin_amdgcn_mfma_f32_32x32x16_bf16(pa1,PK(1),o[d0],0,0,0);
    o[d0]=__builtin_amdgcn_mfma_f32_32x32x16_bf16(pa2,PK(2),o[d0],0,0,0);
    o[d0]=__builtin_amdgcn_mfma_f32_32x32x16_bf16(pa3,PK(3),o[d0],0,0,0);
    #undef PK
  }
}

#ifndef ATTN_STORE16
#define ATTN_STORE16(p,v) (*(u32x4*)(p)=(v))
#endif
template<int THRL,int MODE,int QP,int KP,int VP,int OP> __device__ __forceinline__ void attn_unit(int b,int qb,const bf16*Q,const bf16*__restrict__ K,const bf16*__restrict__ V,bf16*O,char*shm,const float*btab,const bf16*km,int wave_s){
  int tid_=wave_s*64+fresh_lane(); asm volatile("":"+v"(tid_));
  const int tid=tid_,lane=tid&63,r32=lane&31,hi=lane>>5; const int wid=wave_s;
  const long rowbase=(long)b*SEQ; const int q0=qb*QB;
  const bf16*Qw=Q+(rowbase+q0+wid*QBLK)*QP;
  const bf16*Kh=K+rowbase*KP,*Vh=V+rowbase*VP;
  const unsigned lds0=(unsigned)(uintptr_t)shm;
  float*wsf=(float*)(shm+LDS_WS)+wid*64;
  const bf16*ksrc=Kh+(long)lane*KP+wid*8;
  const bf16*vsrc=Vh+(long)(16*(wid&3)+(lane>>2))*VP+(wid>>2)*32+(lane&3)*8;
  const unsigned kdst=lds0+LDS_K+wid*1024, vdst=lds0+LDS_V+wid*1024;
  #define DMA_K(t,slot) glds16(ksrc+(long)(t)*KVBLK*KP,(unsigned)__builtin_amdgcn_readfirstlane(kdst+(slot)))
  #define DMA_V(t,slot) glds16(vsrc+(long)(t)*KVBLK*VP,(unsigned)__builtin_amdgcn_readfirstlane(vdst+(slot)))
  const int vb0=(int)(lds0+LDS_V)+((lane>>4)&1)*32+(lane&3)*8+(4*hi+((lane&15)>>2))*64;
  const char*Kbase=shm+LDS_K; bf16x8 kf[8];
  const lds_cptr shm3=(lds_cptr)shm; const lds_cptr kp0=shm3+LDS_K+hi*1024+r32*16; const lds_cptr vp0=shm3+LDS_V+((lane>>4)&1)*32+(lane&3)*8+(4*hi+((lane&15)>>2))*64;
  const int NT=(q0+QB)/KVBLK;
  DMA_K(0,0);DMA_V(0,0);DMA_K(1,SLOTB);
  bf16x8 qr[4];
  #pragma unroll
  for(int d0=0;d0<4;++d0)qr[d0]=*reinterpret_cast<const bf16x8*>(&Qw[(long)r32*QP+d0*16+hi*8]);
  const float B31=__builtin_bit_cast(float,__builtin_amdgcn_readfirstlane(__builtin_bit_cast(int,btab[TBLW-1])));
  { __attribute__((address_space(3))) float* tw=(__attribute__((address_space(3))) float*)(shm3+TBL_OFF); if(tid<TBLW)tw[tid]=btab[tid]-B31; }
  const __attribute__((address_space(3))) float* tbl=(const __attribute__((address_space(3))) float*)(shm3+TBL_OFF);
  const int qrel=wid*QBLK+r32;
  __attribute__((address_space(3))) unsigned* selw=(__attribute__((address_space(3))) unsigned*)(shm3+TBL_OFF+2048);
  unsigned selpk=0xffffffu;
  if constexpr(MODE==1){
    f32x16 g0=f32x16{},g1=f32x16{};
    #pragma unroll
    for(int d0=0;d0<4;++d0){ const bf16x8 k0=*reinterpret_cast<const bf16x8*>(&km[r32*64+d0*16+hi*8]); const bf16x8 k1=*reinterpret_cast<const bf16x8*>(&km[(32+r32)*64+d0*16+hi*8]);
      g0=__builtin_amdgcn_mfma_f32_32x32x16_bf16(k0,qr[d0],g0,0,0,0); g1=__builtin_amdgcn_mfma_f32_32x32x16_bf16(k1,qr[d0],g1,0,0,0); }
    const int cur=qb;
    #pragma unroll
    for(int r=0;r<16;++r){ const int bk=crow(r,hi); if(bk>=cur)g0[r]=-INFINITY; if(bk+32>=cur)g1[r]=-INFINITY; }
    selpk=0u;
    #pragma unroll
    for(int it=0;it<3;++it){
      float bv=-INFINITY; int bi=255;
      #pragma unroll
      for(int r=0;r<16;++r){ const int bk=crow(r,hi); if(g0[r]>bv||(g0[r]==bv&&g0[r]>-INFINITY&&bk<bi)){bv=g0[r];bi=bk;} }
      #pragma unroll
      for(int r=0;r<16;++r){ const int bk=crow(r,hi)+32; if(g1[r]>bv||(g1[r]==bv&&g1[r]>-INFINITY&&bk<bi)){bv=g1[r];bi=bk;} }
      const float ov=__shfl_xor(bv,32); const int oi=__shfl_xor(bi,32);
      if(ov>bv||(ov==bv&&oi<bi)){bv=ov;bi=oi;}
      selpk|=(unsigned)bi<<(8*it);
      #pragma unroll
      for(int r=0;r<16;++r){ const int bk=crow(r,hi); if(bk==bi)g0[r]=-INFINITY; if(bk+32==bi)g1[r]=-INFINITY; }
    }
    selw[qrel]=selpk;
  }
  float mhat=0.f,l_reg=0.f;f32x16 o[2];o[0]=f32x16{};o[1]=f32x16{};f32x16 negm;
  #pragma unroll
  for(int r=0;r<16;++r)negm[r]=B31;
  asm volatile("":"+v"(negm));
  #define ROWMASK(P0,P1,t) do{ if constexpr(MODE==1){ const unsigned bk_=(unsigned)((t)>>2), sp_=selw[qrel]; const bool sel_=(bk_==(sp_&255u))||(bk_==((sp_>>8)&255u))||(bk_==((sp_>>16)&255u)); \
      _Pragma("unroll") for(int r=0;r<16;++r){P0[r]=sel_?P0[r]:-INFINITY;P1[r]=sel_?P1[r]:-INFINITY;} } }while(0)
  #define NEARB(P0,P1,t) do{ const int tb_=(t)-(NT-6); if(tb_>=0){ const int base_=qrel+128-64*tb_-4*hi; \
      _Pragma("unroll") for(int r=0;r<16;++r){ const int d0_=base_-((r&3)+8*(r>>2)), d1_=d0_-32; \
        P0[r]=(d0_>=0)?P0[r]+tbl[d0_<0?0:d0_]:-INFINITY; P1[r]=(d1_>=0)?P1[r]+tbl[d1_<0?0:d1_]:-INFINITY; } } }while(0)
  #define CMASK(P0,P1,t) do{ if((t)<NT-4){ROWMASK(P0,P1,t);} NEARB(P0,P1,t); }while(0)
  bool resc=false;
  #define START(P0,P1) do{ const float rm=rowmax(P0,P1); resc=false; \
    { const float dl=__builtin_fmaxf(rm,0.f); mhat=fadd_s(mhat,dl); \
      _Pragma("unroll") for(int r=0;r<16;++r){P0[r]=fsub_s(P0[r],dl);P1[r]=fsub_s(P1[r],dl);} \
      _Pragma("unroll") for(int r=0;r<16;++r)negm[r]=B31-mhat; asm volatile("":"+v"(negm)); } \
    _Pragma("unroll") for(int r=0;r<16;++r)P0[r]=__builtin_amdgcn_exp2f(P0[r]); }while(0)
  #define RESC() do{ if(resc){ asm volatile("s_waitcnt lgkmcnt(0)":::"memory"); \
      _Pragma("unroll") for(int d_=0;d_<2;++d_) _Pragma("unroll") for(int r=0;r<16;++r)o[d_][r]*=wsf[crow(r,hi)]; } }while(0)
  f32x16 pA0,pA1,pB0,pB1;
  int sl_prev=0,sl_cur=0,sl_next=SLOTB;
  #define ROT() do{sl_prev=sl_cur;sl_cur=sl_next;sl_next=(sl_next==(NSLOT-1)*SLOTB)?0:sl_next+SLOTB;}while(0)
  DMA_K(2,2*SLOTB);
  WAIT_BAR(3);
  qkt(pA0,pA1,Kbase,qr,negm,r32,hi);asm volatile("s_nop 15\n\ts_nop 7":"+v"(pA0),"+v"(pA1));CMASK(pA0,pA1,0);
  START(pA0,pA1);
  _Pragma("unroll") for(int r=0;r<16;++r)pA1[r]=__builtin_amdgcn_exp2f(pA1[r]);
  WAIT_BAR(0);
  DMA_K(3,0);DMA_V(1,SLOTB);
  ROT();
  kload8(kf,kp0+sl_cur);
  WAIT_BAR(2);
  s16x4 vlo[8],vhi[8]; u32x4 pw0,pw1,pw2,pw3;
  #define PKW(P,B) cvtpk_s(P[B],P[B+1])
  #define PAF(k) __builtin_bit_cast(bf16x8,pw##k)
  #define VFR(i) (bf16x8){vlo[i][0],vlo[i][1],vlo[i][2],vlo[i][3],vhi[i][0],vhi[i][1],vhi[i][2],vhi[i][3]}
  #define PIN(x) asm volatile("":"+v"(x))
  #define MX3(a,b,c) __builtin_fmaxf(__builtin_fmaxf((a),(b)),(c))
  #define GAPA(MF,A0,A1,A2,A3,W0,W1,PW) do{ MF; sacc+=A0; sacc+=A1; sacc+=A2; sacc+=A3; PIN(sacc); W0; W1; PIN(PW); SBAR(); }while(0)
  #define EX(v) __builtin_amdgcn_exp2f(v)
  #define GAPB(MF,X,B) do{ MF; X[B]=EX(X[B]); X[B+1]=EX(X[B+1]); X[B+2]=EX(X[B+2]); X[B+3]=EX(X[B+3]); PIN(X); SBAR(); }while(0)
  #define VRD(i) do{ vlo[i]=vtr(vp_+(((i)>>2)*4096+((i)&3)*1024)); vhi[i]=vtr(vp_+(((i)>>2)*4096+((i)&3)*1024+512)); }while(0)
  #define KRD(G,j) do{ if(G){ kload2(kf,kp0+sl_next,j); SBAR(); } }while(0)
  #define STEP(C0,C1,P0,P1,t,GK,GV,GL) do{ SBAR(); \
    const lds_cptr vp_=vp0+sl_prev; \
    VRD(0); SBAR(); float sacc=(P0[0]+P0[1]); \
    GAPA(C0=__builtin_amdgcn_mfma_f32_32x32x16_bf16(kf[0],qr[0],negm,0,0,0), P0[2],P0[3],P0[4],P0[5],     pw0[0]=PKW(P0,0), pw0[1]=PKW(P0,2), pw0); \
    VRD(4); SBAR(); GAPA(C1=__builtin_amdgcn_mfma_f32_32x32x16_bf16(kf[1],qr[0],negm,0,0,0), P0[6],P0[7],P0[8],P0[9],     pw0[2]=PKW(P0,4), pw0[3]=PKW(P0,6), pw0); \
    VRD(1); SBAR(); GAPA(C0=__builtin_amdgcn_mfma_f32_32x32x16_bf16(kf[2],qr[1],C0,0,0,0),   P0[10],P0[11],P0[12],P0[13], pw1[0]=PKW(P0,8), pw1[1]=PKW(P0,10), pw1); \
    VRD(5); SBAR(); GAPA(C1=__builtin_amdgcn_mfma_f32_32x32x16_bf16(kf[3],qr[1],C1,0,0,0),   P0[14],P0[15],P1[0],P1[1],   pw1[2]=PKW(P0,12),pw1[3]=PKW(P0,14), pw1); \
    VRD(2); SBAR(); GAPA(C0=__builtin_amdgcn_mfma_f32_32x32x16_bf16(kf[4],qr[2],C0,0,0,0),   P1[2],P1[3],P1[4],P1[5],     pw2[0]=PKW(P1,0), pw2[1]=PKW(P1,2), pw2); \
    VRD(6); SBAR(); GAPA(C1=__builtin_amdgcn_mfma_f32_32x32x16_bf16(kf[5],qr[2],C1,0,0,0),   P1[6],P1[7],P1[8],P1[9],     pw2[2]=PKW(P1,4), pw2[3]=PKW(P1,6), pw2); \
    VRD(3); SBAR(); GAPA(C0=__builtin_amdgcn_mfma_f32_32x32x16_bf16(kf[6],qr[3],C0,0,0,0),   P1[10],P1[11],P1[12],P1[13], pw3[0]=PKW(P1,8), pw3[1]=PKW(P1,10), pw3); \
    VRD(7); SBAR(); GAPA(C1=__builtin_amdgcn_mfma_f32_32x32x16_bf16(kf[7],qr[3],C1,0,0,0),   P1[14],P1[15],0.f,0.f,       pw3[2]=PKW(P1,12),pw3[3]=PKW(P1,14), pw3); \
    l_reg+=sacc; \
    if(GK){DMA_K((t)+3,sl_cur);} if(GV){DMA_V((t)+1,sl_next);} \
    CMASK(C0,C1,t); \
    { float a=MX3(C0[0],C0[1],C1[0]),b=MX3(C0[2],C0[3],C1[1]); a=MX3(a,C1[2],C1[3]); \
      _Pragma("unroll") for(int r=4;r<16;r+=4){a=MX3(a,C0[r],C0[r+1]);b=MX3(b,C0[r+2],C0[r+3]);a=MX3(a,C1[r],C1[r+1]);b=MX3(b,C1[r+2],C1[r+3]);} \
      float rm=__builtin_fmaxf(a,b); { auto rr=__builtin_amdgcn_permlane32_swap(__float_as_uint(rm),__float_as_uint(rm),false,false); rm=__builtin_fmaxf(__uint_as_float(rr[0]),__uint_as_float(rr[1])); } \
      resc=false; \
      if(__builtin_expect(__any(rm>(float)THRL),0)){ const float dl=__builtin_fmaxf(rm,0.f); mhat+=dl; \
        _Pragma("unroll") for(int r=0;r<16;++r){C0[r]-=dl;C1[r]-=dl;} \
        _Pragma("unroll") for(int r=0;r<16;++r)negm[r]=B31-mhat; asm volatile("":"+v"(negm)); \
        const float f=__builtin_amdgcn_exp2f(-dl); l_reg*=f; if(hi==0)wsf[r32]=f; resc=true; } } \
    SBAR(); \
    GAPB(o[0]=__builtin_amdgcn_mfma_f32_32x32x16_bf16(PAF(0),VFR(0),o[0],0,0,0), C0,0); \
    GAPB(o[1]=__builtin_amdgcn_mfma_f32_32x32x16_bf16(PAF(0),VFR(4),o[1],0,0,0), C0,4); \
    KRD(GL,0); GAPB(o[0]=__builtin_amdgcn_mfma_f32_32x32x16_bf16(PAF(1),VFR(1),o[0],0,0,0), C0,8); \
    KRD(GL,1); GAPB(o[1]=__builtin_amdgcn_mfma_f32_32x32x16_bf16(PAF(1),VFR(5),o[1],0,0,0), C0,12); \
    KRD(GL,2); GAPB(o[0]=__builtin_amdgcn_mfma_f32_32x32x16_bf16(PAF(2),VFR(2),o[0],0,0,0), C1,0); \
    KRD(GL,3); GAPB(o[1]=__builtin_amdgcn_mfma_f32_32x32x16_bf16(PAF(2),VFR(6),o[1],0,0,0), C1,4); \
    GAPB(o[0]=__builtin_amdgcn_mfma_f32_32x32x16_bf16(PAF(3),VFR(3),o[0],0,0,0), C1,8); \
    GAPB(o[1]=__builtin_amdgcn_mfma_f32_32x32x16_bf16(PAF(3),VFR(7),o[1],0,0,0), C1,12); \
    }while(0)
  int t=1;
  #undef CMASK
  #define CMASK(P0,P1,t) ROWMASK(P0,P1,t)
  for(;t+7<NT;t+=2){
    STEP(pB0,pB1,pA0,pA1,t,true,true,true);     WAIT_BAR(2); RESC(); ROT();
    STEP(pA0,pA1,pB0,pB1,t+1,true,true,true);   WAIT_BAR(2); RESC(); ROT();
  }
  #undef CMASK
  #define CMASK(P0,P1,t) do{ if((t)<NT-4){ROWMASK(P0,P1,t);} NEARB(P0,P1,t); }while(0)
  #define ENDW(tt) do{ if((tt)+3<NT){WAIT_BAR(2);} else if((tt)+2<NT){WAIT_BAR(1);} else {WAIT_BAR(0);} }while(0)
  for(;t+1<NT;t+=2){
    STEP(pB0,pB1,pA0,pA1,t,(t+3<NT),(t+1<NT),(t+1<NT));       ENDW(t);   RESC(); ROT();
    STEP(pA0,pA1,pB0,pB1,t+1,(t+4<NT),(t+2<NT),(t+2<NT));     ENDW(t+1); RESC(); ROT();
  }
  STEP(pB0,pB1,pA0,pA1,NT-1,false,false,false); RESC();
  { float sacc=pB0[0]+pB0[1]; _Pragma("unroll") for(int r=2;r<16;++r)sacc+=pB0[r]; _Pragma("unroll") for(int r=0;r<16;++r)sacc+=pB1[r]; l_reg+=sacc;
    pw0=(u32x4){PKW(pB0,0),PKW(pB0,2),PKW(pB0,4),PKW(pB0,6)};pw1=(u32x4){PKW(pB0,8),PKW(pB0,10),PKW(pB0,12),PKW(pB0,14)};pw2=(u32x4){PKW(pB1,0),PKW(pB1,2),PKW(pB1,4),PKW(pB1,6)};pw3=(u32x4){PKW(pB1,8),PKW(pB1,10),PKW(pB1,12),PKW(pB1,14)};
    SBAR(); pv(o,vb0+sl_cur,PAF(0),PAF(1),PAF(2),PAF(3)); }
  #undef PKW
  #undef PAF
  #undef VFR
  #undef PIN
  #undef MX3
  #undef GAPA
  #undef GAPB
  #undef EX
  #undef VRD
  #undef KRD
  #undef STEP
  #undef ENDW
  {auto rr=__builtin_amdgcn_permlane32_swap(__float_as_uint(l_reg),__float_as_uint(l_reg),false,false);l_reg=__uint_as_float(rr[0])+__uint_as_float(rr[1]);}
  if(hi==0)wsf[32+r32]=l_reg;asm volatile("s_waitcnt lgkmcnt(0)":::"memory");
  float rli[16];
  #pragma unroll
  for(int r=0;r<16;++r)rli[r]=__builtin_amdgcn_rcpf(wsf[32+crow(r,hi)]);
  bf16*Ow=O+(rowbase+q0+wid*QBLK)*OP;
  { bf16*stg=(bf16*)(shm+LDS_OST)+wid*2048;
    #pragma unroll
    for(int r=0;r<16;++r){const int orow=crow(r,hi);
      #pragma unroll
      for(int d0=0;d0<2;++d0)stg[orow*64+d0*32+r32]=__float2bfloat16(o[d0][r]*rli[r]);}
    asm volatile("s_waitcnt lgkmcnt(0)":::"memory");
    #pragma unroll
    for(int i=0;i<4;++i){const int row=i*8+(lane>>3),ch=lane&7; const u32x4 v=*(const u32x4*)(stg+row*64+ch*8); ATTN_STORE16(Ow+(long)row*OP+ch*8,v);} }
  asm volatile("s_waitcnt lgkmcnt(0)\n\ts_barrier":::"memory");
  #undef DMA_K
  #undef DMA_V
  #undef CMASK
  #undef ROWMASK
  #undef NEARB
  #undef START
  #undef RESC
  #undef ROT
}
template<int THRL,int QP,int KP,int VP,int OP> __device__ __forceinline__ void attn_unit128(int b,int qb,const bf16*Q,const bf16*__restrict__ K,const bf16*__restrict__ V,bf16*O,char*shm,const float*btab,int wave_s,bf16*O1T,int fin,float lam,const float*subg){
  constexpr int L_K=0,L_V=3*SLOTB,L_WS=L_V+3*2*SLOTB,L_OST=L_WS+NW*64*4,L_TBL=110592;
  int tid_=wave_s*64+fresh_lane(); asm volatile("":"+v"(tid_));
  const int tid=tid_,lane=tid&63,r32=lane&31,hi=lane>>5; const int wid=wave_s;
  const long rowbase=(long)b*SEQ; const int q0=qb*QB;
  const bf16*Qw=Q+(rowbase+q0+wid*QBLK)*QP;
  const bf16*Kh=K+rowbase*KP,*Vh=V+rowbase*VP;
  const unsigned lds0=(unsigned)(uintptr_t)shm;
  float*wsf=(float*)(shm+L_WS)+wid*64;
  const bf16*ksrc=Kh+(long)lane*KP+wid*8;
  const bf16*vsrc=Vh+(long)(16*(wid&3)+(lane>>2))*VP+(wid>>2)*32+(lane&3)*8;
  const unsigned kdst=lds0+L_K+wid*1024, vdst=lds0+L_V+wid*1024;
  #define DMA_K(t,slot) glds16(ksrc+(long)(t)*KVBLK*KP,(unsigned)__builtin_amdgcn_readfirstlane(kdst+(slot)))
  #define DMA_V(t,slot) do{ glds16(vsrc+(long)(t)*KVBLK*VP,(unsigned)__builtin_amdgcn_readfirstlane(vdst+2*(slot))); glds16(vsrc+64+(long)(t)*KVBLK*VP,(unsigned)__builtin_amdgcn_readfirstlane(vdst+2*(slot)+8192)); }while(0)
  const int vb0=(int)(lds0+L_V)+((lane>>4)&1)*32+(lane&3)*8+(4*hi+((lane&15)>>2))*64;
  const char*Kbase=shm+L_K; bf16x8 kf[8];
  const lds_cptr shm3=(lds_cptr)shm; const lds_cptr kp0=shm3+L_K+hi*1024+r32*16; const lds_cptr vp0=shm3+L_V+((lane>>4)&1)*32+(lane&3)*8+(4*hi+((lane&15)>>2))*64;
  const int NT=(q0+QB)/KVBLK;
  DMA_K(0,0);DMA_V(0,0);DMA_K(1,SLOTB);
  bf16x8 qr[4];
  #pragma unroll
  for(int d0=0;d0<4;++d0)qr[d0]=*reinterpret_cast<const bf16x8*>(&Qw[(long)r32*QP+d0*16+hi*8]);
  const float B31=__builtin_bit_cast(float,__builtin_amdgcn_readfirstlane(__builtin_bit_cast(int,btab[TBLW-1])));
  { __attribute__((address_space(3))) float* tw=(__attribute__((address_space(3))) float*)(shm3+L_TBL); if(tid<TBLW)tw[tid]=btab[tid]-B31; }
  const __attribute__((address_space(3))) float* tbl=(const __attribute__((address_space(3))) float*)(shm3+L_TBL);
  const int qrel=wid*QBLK+r32;
  float mhat=0.f,l_reg=0.f;f32x16 o[4];o[0]=f32x16{};o[1]=f32x16{};o[2]=f32x16{};o[3]=f32x16{};
  #define ROWMASK(P0,P1,t) do{}while(0)
  #define NEARB(P0,P1,t) do{ const int tb_=(t)-(NT-6); if(tb_>=0){ const int base_=qrel+128-64*tb_-4*hi; \
      _Pragma("unroll") for(int r=0;r<16;++r){ const int d0_=base_-((r&3)+8*(r>>2)), d1_=d0_-32; \
        P0[r]=(d0_>=0)?P0[r]+tbl[d0_<0?0:d0_]:-INFINITY; P1[r]=(d1_>=0)?P1[r]+tbl[d1_<0?0:d1_]:-INFINITY; } } }while(0)
  #define CMASK(P0,P1,t) do{ if((t)<NT-4){ROWMASK(P0,P1,t);} NEARB(P0,P1,t); }while(0)
  bool resc=false;
  #define START(P0,P1) do{ const float rm=rowmax(P0,P1); resc=false; \
    { const float dl=__builtin_fmaxf(rm,0.f); mhat=fadd_s(mhat,dl); \
      _Pragma("unroll") for(int r=0;r<16;++r){P0[r]=fsub_s(P0[r],dl);P1[r]=fsub_s(P1[r],dl);} \
      } \
    _Pragma("unroll") for(int r=0;r<16;++r)P0[r]=__builtin_amdgcn_exp2f(P0[r]); }while(0)
  #define RESC() do{ if(resc){ asm volatile("s_waitcnt lgkmcnt(0)":::"memory"); \
      _Pragma("unroll") for(int d_=0;d_<4;++d_) _Pragma("unroll") for(int r=0;r<16;++r)o[d_][r]*=wsf[crow(r,hi)]; } }while(0)
  f32x16 pA0,pA1,pB0,pB1;
  int sl_prev=0,sl_cur=0,sl_next=SLOTB;
  #define ROT() do{sl_prev=sl_cur;sl_cur=sl_next;sl_next=(sl_next==(NSLOT-1)*SLOTB)?0:sl_next+SLOTB;}while(0)
  DMA_K(2,2*SLOTB);
  WAIT_BAR(4);
  qkt(pA0,pA1,Kbase,qr,f32x16{},r32,hi);asm volatile("s_nop 15\n\ts_nop 7":"+v"(pA0),"+v"(pA1));CMASK(pA0,pA1,0);
  START(pA0,pA1);
  _Pragma("unroll") for(int r=0;r<16;++r)pA1[r]=__builtin_amdgcn_exp2f(pA1[r]);
  WAIT_BAR(0);
  DMA_K(3,0);DMA_V(1,SLOTB);
  ROT();
  kload8(kf,kp0+sl_cur);
  WAIT_BAR(3);
  s16x4 vlo[8],vhi[8]; u32x4 pw0,pw1,pw2,pw3;
  #define PKW(P,B) cvtpk_s(P[B],P[B+1])
  #define PAF(k) __builtin_bit_cast(bf16x8,pw##k)
  #define VFR(i) (bf16x8){vlo[i][0],vlo[i][1],vlo[i][2],vlo[i][3],vhi[i][0],vhi[i][1],vhi[i][2],vhi[i][3]}
  #define PIN(x) asm volatile("":"+v"(x))
  #define MX3(a,b,c) __builtin_fmaxf(__builtin_fmaxf((a),(b)),(c))
  #define GAPA(MF,A0,A1,A2,A3,W0,W1,PW) do{ MF; sacc+=A0; sacc+=A1; sacc+=A2; sacc+=A3; PIN(sacc); W0; W1; PIN(PW); SBAR(); }while(0)
  #define EX(v) __builtin_amdgcn_exp2f(v)
  #define GAPB(MF,X,B) do{ MF; X[B]=EX(X[B]-mhat); X[B+1]=EX(X[B+1]-mhat); X[B+2]=EX(X[B+2]-mhat); X[B+3]=EX(X[B+3]-mhat); PIN(X); SBAR(); }while(0)
  #define VRD(i) do{ vlo[i]=vtr(vp_+(((i)>>2)*4096+((i)&3)*1024)); vhi[i]=vtr(vp_+(((i)>>2)*4096+((i)&3)*1024+512)); }while(0)
  #define VRD2(i) do{ vlo[i]=vtr(vp_+(8192+((i)>>2)*4096+((i)&3)*1024)); vhi[i]=vtr(vp_+(8192+((i)>>2)*4096+((i)&3)*1024+512)); SBAR(); }while(0)
  #define WFR(i) VFR(i)
  #define MFB2(D,K_,I) do{ o[D]=__builtin_amdgcn_mfma_f32_32x32x16_bf16(PAF(K_),WFR(I),o[D],0,0,0); SBAR(); }while(0)
  #define KRD(G,j) do{ if(G){ kload2(kf,kp0+sl_next,j); SBAR(); } }while(0)
  #define STEP(C0,C1,P0,P1,t,GK,GV,GL) do{ SBAR(); \
    const lds_cptr vp_=vp0+2*sl_prev; \
    VRD(0); SBAR(); float sacc=(P0[0]+P0[1]); \
    GAPA(C0=__builtin_amdgcn_mfma_f32_32x32x16_bf16(kf[0],qr[0],f32x16{},0,0,0), P0[2],P0[3],P0[4],P0[5],     pw0[0]=PKW(P0,0), pw0[1]=PKW(P0,2), pw0); \
    VRD(4); SBAR(); GAPA(C1=__builtin_amdgcn_mfma_f32_32x32x16_bf16(kf[1],qr[0],f32x16{},0,0,0), P0[6],P0[7],P0[8],P0[9],     pw0[2]=PKW(P0,4), pw0[3]=PKW(P0,6), pw0); \
    VRD(1); SBAR(); GAPA(C0=__builtin_amdgcn_mfma_f32_32x32x16_bf16(kf[2],qr[1],C0,0,0,0),   P0[10],P0[11],P0[12],P0[13], pw1[0]=PKW(P0,8), pw1[1]=PKW(P0,10), pw1); \
    VRD(5); SBAR(); GAPA(C1=__builtin_amdgcn_mfma_f32_32x32x16_bf16(kf[3],qr[1],C1,0,0,0),   P0[14],P0[15],P1[0],P1[1],   pw1[2]=PKW(P0,12),pw1[3]=PKW(P0,14), pw1); \
    VRD(2); SBAR(); GAPA(C0=__builtin_amdgcn_mfma_f32_32x32x16_bf16(kf[4],qr[2],C0,0,0,0),   P1[2],P1[3],P1[4],P1[5],     pw2[0]=PKW(P1,0), pw2[1]=PKW(P1,2), pw2); \
    VRD(6); SBAR(); GAPA(C1=__builtin_amdgcn_mfma_f32_32x32x16_bf16(kf[5],qr[2],C1,0,0,0),   P1[6],P1[7],P1[8],P1[9],     pw2[2]=PKW(P1,4), pw2[3]=PKW(P1,6), pw2); \
    VRD(3); SBAR(); GAPA(C0=__builtin_amdgcn_mfma_f32_32x32x16_bf16(kf[6],qr[3],C0,0,0,0),   P1[10],P1[11],P1[12],P1[13], pw3[0]=PKW(P1,8), pw3[1]=PKW(P1,10), pw3); \
    VRD(7); SBAR(); GAPA(C1=__builtin_amdgcn_mfma_f32_32x32x16_bf16(kf[7],qr[3],C1,0,0,0),   P1[14],P1[15],0.f,0.f,       pw3[2]=PKW(P1,12),pw3[3]=PKW(P1,14), pw3); \
    l_reg+=sacc; \
    if(GK){DMA_K((t)+3,sl_cur);} if(GV){DMA_V((t)+1,sl_next);} \
    CMASK(C0,C1,t); \
    { float a=MX3(C0[0],C0[1],C1[0]),b=MX3(C0[2],C0[3],C1[1]); a=MX3(a,C1[2],C1[3]); \
      _Pragma("unroll") for(int r=4;r<16;r+=4){a=MX3(a,C0[r],C0[r+1]);b=MX3(b,C0[r+2],C0[r+3]);a=MX3(a,C1[r],C1[r+1]);b=MX3(b,C1[r+2],C1[r+3]);} \
      float rm=__builtin_fmaxf(a,b); { auto rr=__builtin_amdgcn_permlane32_swap(__float_as_uint(rm),__float_as_uint(rm),false,false); rm=__builtin_fmaxf(__uint_as_float(rr[0]),__uint_as_float(rr[1])); } \
      resc=false; \
      if(__builtin_expect(__any(rm-mhat>(float)THRL),0)){ const float dl=__builtin_fmaxf(rm-mhat,0.f); mhat+=dl; \
        const float f=__builtin_amdgcn_exp2f(-dl); l_reg*=f; { const int l_=fresh_lane(); if(l_<32)((__attribute__((address_space(3))) float*)(shm3+L_WS+wid*256))[l_]=f; } resc=true; } } \
    SBAR(); \
    GAPB(o[0]=__builtin_amdgcn_mfma_f32_32x32x16_bf16(PAF(0),VFR(0),o[0],0,0,0), C0,0); VRD2(0); \
    GAPB(o[1]=__builtin_amdgcn_mfma_f32_32x32x16_bf16(PAF(0),VFR(4),o[1],0,0,0), C0,4); VRD2(4); \
    KRD(GL,0); GAPB(o[0]=__builtin_amdgcn_mfma_f32_32x32x16_bf16(PAF(1),VFR(1),o[0],0,0,0), C0,8); VRD2(1); \
    KRD(GL,1); GAPB(o[1]=__builtin_amdgcn_mfma_f32_32x32x16_bf16(PAF(1),VFR(5),o[1],0,0,0), C0,12); VRD2(5); \
    KRD(GL,2); GAPB(o[0]=__builtin_amdgcn_mfma_f32_32x32x16_bf16(PAF(2),VFR(2),o[0],0,0,0), C1,0); VRD2(2); \
    KRD(GL,3); GAPB(o[1]=__builtin_amdgcn_mfma_f32_32x32x16_bf16(PAF(2),VFR(6),o[1],0,0,0), C1,4); VRD2(6); \
    GAPB(o[0]=__builtin_amdgcn_mfma_f32_32x32x16_bf16(PAF(3),VFR(3),o[0],0,0,0), C1,8); VRD2(3); \
    GAPB(o[1]=__builtin_amdgcn_mfma_f32_32x32x16_bf16(PAF(3),VFR(7),o[1],0,0,0), C1,12); VRD2(7); \
    MFB2(2,0,0); MFB2(3,0,4); MFB2(2,1,1); MFB2(3,1,5); MFB2(2,2,2); MFB2(3,2,6); MFB2(2,3,3); MFB2(3,3,7); \
    }while(0)
  int t=1;
  #undef CMASK
  #define CMASK(P0,P1,t) ROWMASK(P0,P1,t)
  for(;t+7<NT;t+=2){
    STEP(pB0,pB1,pA0,pA1,t,true,true,true);     WAIT_BAR(3); RESC(); ROT();
    STEP(pA0,pA1,pB0,pB1,t+1,true,true,true);   WAIT_BAR(3); RESC(); ROT();
  }
  #undef CMASK
  #define CMASK(P0,P1,t) do{ if((t)<NT-4){ROWMASK(P0,P1,t);} NEARB(P0,P1,t); }while(0)
  #define ENDW(tt) do{ if((tt)+3<NT){WAIT_BAR(3);} else if((tt)+2<NT){WAIT_BAR(2);} else {WAIT_BAR(0);} }while(0)
  for(;t+1<NT;t+=2){
    STEP(pB0,pB1,pA0,pA1,t,(t+3<NT),(t+1<NT),(t+1<NT));       ENDW(t);   RESC(); ROT();
    STEP(pA0,pA1,pB0,pB1,t+1,(t+4<NT),(t+2<NT),(t+2<NT));     ENDW(t+1); RESC(); ROT();
  }
  STEP(pB0,pB1,pA0,pA1,NT-1,false,false,false); RESC();
  { float sacc=pB0[0]+pB0[1]; _Pragma("unroll") for(int r=2;r<16;++r)sacc+=pB0[r]; _Pragma("unroll") for(int r=0;r<16;++r)sacc+=pB1[r]; l_reg+=sacc;
    pw0=(u32x4){PKW(pB0,0),PKW(pB0,2),PKW(pB0,4),PKW(pB0,6)};pw1=(u32x4){PKW(pB0,8),PKW(pB0,10),PKW(pB0,12),PKW(pB0,14)};pw2=(u32x4){PKW(pB1,0),PKW(pB1,2),PKW(pB1,4),PKW(pB1,6)};pw3=(u32x4){PKW(pB1,8),PKW(pB1,10),PKW(pB1,12),PKW(pB1,14)};
    SBAR(); { const int l2=fresh_lane(); const int vbe=(int)(lds0+L_V)+((l2>>4)&1)*32+(l2&3)*8+(4*(l2>>5)+((l2&15)>>2))*64;
      pv(o,vbe+2*sl_cur,PAF(0),PAF(1),PAF(2),PAF(3)); pv(o+2,vbe+2*sl_cur+8192,PAF(0),PAF(1),PAF(2),PAF(3)); } }
  #undef PKW
  #undef PAF
  #undef VFR
  #undef PIN
  #undef MX3
  #undef GAPA
  #undef GAPB
  #undef EX
  #undef VRD
  #undef KRD
  #undef VRD2
  #undef WFR
  #undef MFB2
  #undef STEP
  #undef ENDW
  {auto rr=__builtin_amdgcn_permlane32_swap(__float_as_uint(l_reg),__float_as_uint(l_reg),false,false);l_reg=__uint_as_float(rr[0])+__uint_as_float(rr[1]);}
  const int l3=fresh_lane(), r32e=l3&31, hie=l3>>5; __attribute__((address_space(3))) float* wse=(__attribute__((address_space(3))) float*)(shm3+L_WS+wid*256);
  if(hie==0)wse[32+r32e]=l_reg;asm volatile("s_waitcnt lgkmcnt(0)":::"memory");
  float rli[16];
  #pragma unroll
  for(int r=0;r<16;++r)rli[r]=__builtin_amdgcn_rcpf(wse[32+crow(r,hie)]);
  bf16*Ow=O+(rowbase+q0+wid*QBLK)*OP;
  bf16*O1w=O1T+(rowbase+q0+wid*QBLK)*OP;
  { bf16*stg=(bf16*)(shm+L_OST)+wid*2048;
    u32x4 keep[2][4]; const int le=fresh_lane(), erow=le>>3, ech=le&7;
    #pragma unroll
    for(int hf=0;hf<2;++hf){
      #pragma unroll
      for(int r=0;r<16;++r){const int orow=crow(r,hie);
        #pragma unroll
        for(int d0=0;d0<2;++d0)stg[orow*64+d0*32+r32e]=__float2bfloat16(o[2*hf+d0][r]*rli[r]);}
      asm volatile("s_waitcnt lgkmcnt(0)":::"memory");
      #pragma unroll
      for(int i=0;i<4;++i){const int row=i*8+erow,ch=ech; const u32x4 v=*(const u32x4*)(stg+row*64+ch*8); keep[hf][i]=v; if(!fin)ATTN_STORE16(O1w+(long)row*OP+hf*64+ch*8,v);}
      asm volatile("s_waitcnt lgkmcnt(0)":::"memory"); }
    if(fin){
      const int ch=ech; float sg[16]; asm volatile("":"+s"(subg));
      #pragma unroll
      for(int j=0;j<8;++j){sg[j]=subg[ch*8+j]*0.8f;sg[8+j]=subg[64+ch*8+j]*0.8f;}
      #pragma unroll
      for(int i=0;i<4;++i){const int row=i*8+erow; float d[16]; float ss=0.f;
        #pragma unroll
        for(int hf=0;hf<2;++hf){ const u32x4 a=*(const u32x4*)(O1w+(long)row*OP+hf*64+ch*8); const u32x4 c=keep[hf][i];
          #pragma unroll
          for(int w=0;w<4;++w){ const float a0=__builtin_bit_cast(float,a[w]<<16),a1=__builtin_bit_cast(float,a[w]&0xffff0000u),c0=__builtin_bit_cast(float,c[w]<<16),c1=__builtin_bit_cast(float,c[w]&0xffff0000u);
            d[hf*8+2*w]=a0-lam*c0; d[hf*8+2*w+1]=a1-lam*c1; } }
        #pragma unroll
        for(int j=0;j<16;++j)ss+=d[j]*d[j];
        ss+=__builtin_bit_cast(float,__builtin_amdgcn_update_dpp(0,__builtin_bit_cast(int,ss),0xB1,0xf,0xf,true));
        ss+=__builtin_bit_cast(float,__builtin_amdgcn_update_dpp(0,__builtin_bit_cast(int,ss),0x4E,0xf,0xf,true));
        ss+=__builtin_bit_cast(float,__builtin_amdgcn_update_dpp(0,__builtin_bit_cast(int,ss),0x141,0xf,0xf,true));
        const float rs=1.f/sqrtf(ss*(1.f/128.f)+1e-5f);
        #pragma unroll
        for(int hf=0;hf<2;++hf){ u32x4 w; w[0]=cvtpk_s(d[hf*8]*rs*sg[hf*8],d[hf*8+1]*rs*sg[hf*8+1]); w[1]=cvtpk_s(d[hf*8+2]*rs*sg[hf*8+2],d[hf*8+3]*rs*sg[hf*8+3]);
          w[2]=cvtpk_s(d[hf*8+4]*rs*sg[hf*8+4],d[hf*8+5]*rs*sg[hf*8+5]); w[3]=cvtpk_s(d[hf*8+6]*rs*sg[hf*8+6],d[hf*8+7]*rs*sg[hf*8+7]);
          ATTN_STORE16(Ow+(long)row*OP+hf*64+ch*8,w); } } } }
  asm volatile("s_waitcnt lgkmcnt(0)\n\ts_barrier":::"memory");
  #undef DMA_K
  #undef DMA_V
  #undef CMASK
  #undef ROWMASK
  #undef NEARB
  #undef START
  #undef RESC
  #undef ROT
}

constexpr int ATTN_LDS_BYTES=TBL_OFF+2048+1024;
#undef SBAR
#undef WAIT_BAR
}
#define PG8_SP2 true
#define PG8_ALIGN true
typedef unsigned short bf16_t;
typedef float f32x4 __attribute__((ext_vector_type(4)));
typedef unsigned u32x4 __attribute__((ext_vector_type(4)));
typedef unsigned u32x2 __attribute__((ext_vector_type(2)));
#define LAS __attribute__((address_space(3)))
constexpr int BATCH = 2, SEQ = 16384, DM = 1024, MTOK = BATCH * SEQ, NPROJ = 4608, NGATE = 2048, NIN = 6656, FF = 4096, NMEM = 256;
constexpr float LN_EPS = 1e-5f, ALPHA = 1.189207115002721f, LOG2E = 1.4426950408889634f;
constexpr float C2 = 0.125f * LOG2E, XC2 = 0.0625f * LOG2E, LAM_INIT = 0.2f;
constexpr size_t MiB = 1u << 20;
constexpr size_t WS_TAB = 1 * MiB, WS_KMEAN = WS_TAB + 65536;
constexpr size_t WS_WIN = 2 * MiB, WS_WBD = 15 * MiB, WS_WBM = 17 * MiB, WS_WOUT = 18 * MiB, WS_WQ = 20 * MiB, WS_WK = 22 * MiB, WS_WV = 24 * MiB, WS_WO = 26 * MiB, WS_W1 = 28 * MiB, WS_W2 = 36 * MiB;
constexpr size_t WS_MEMB = 44 * MiB, WS_KX = 45 * MiB, WS_VXT = 46 * MiB;
constexpr size_t WS_HB = 48 * MiB, WS_X1 = 112 * MiB, WS_QD = 176 * MiB, WS_KD = 240 * MiB, WS_VD = 304 * MiB, WS_MQ = 368 * MiB, WS_MK = 400 * MiB, WS_MV = 432 * MiB, WS_END = 464 * MiB;
constexpr int NWAVES = 8, LDS_BYTES = 147456;
constexpr int BIASW = 384;

__device__ __forceinline__ unsigned f2bf(float f) { unsigned u = __builtin_bit_cast(unsigned, f); return (u + 0x7fffu + ((u >> 16) & 1u)) >> 16; }
__device__ __forceinline__ unsigned pk2(float lo, float hi) { unsigned r; asm("v_cvt_pk_bf16_f32 %0, %1, %2" : "=v"(r) : "v"(lo), "v"(hi)); return r; }
__device__ __forceinline__ float bflo(unsigned u) { return __builtin_bit_cast(float, u << 16); }
__device__ __forceinline__ float bfhi(unsigned u) { return __builtin_bit_cast(float, u & 0xffff0000u); }
__device__ __forceinline__ float wave_sum(float v) {
#pragma unroll
    for (int o = 1; o < 64; o <<= 1) v += __shfl_xor(v, o);
    return v;
}
__device__ __forceinline__ void store8bf(bf16_t* p, const float (&v)[8]) { u32x4 w; w.x = pk2(v[0], v[1]); w.y = pk2(v[2], v[3]); w.z = pk2(v[4], v[5]); w.w = pk2(v[6], v[7]); *(u32x4*)p = w; }
__device__ __forceinline__ void load8bf(const bf16_t* p, float (&v)[8]) { const u32x4 w = *(const u32x4*)p; v[0] = bflo(w.x); v[1] = bfhi(w.x); v[2] = bflo(w.y); v[3] = bfhi(w.y); v[4] = bflo(w.z); v[5] = bfhi(w.z); v[6] = bflo(w.w); v[7] = bfhi(w.w); }

enum { EK_PROJ = 0, EK_GATE, EK_T, EK_MIX, EK_RES, EK_SCALE, EK_RELU2, EK_F32 };
template <int KIND> struct Epi {
    static constexpr bool PERM = true, AFTER_DRAIN = false;
    int ldc; float scale; bf16_t* o; float* of; const bf16_t* gsrc; const float* aux; unsigned char* ws;
    __device__ __forceinline__ void put8(int row, int col0, float (&v)[8]) const {
        switch (KIND) {
        case EK_PROJ: {
            const int t = col0 >> 8; size_t base; int pitch, c; float sc = 1.f;
            if (t < 4) { base = WS_QD; pitch = 1024; c = col0; sc = C2; } else if (t < 8) { base = WS_KD; pitch = 1024; c = col0 - 1024; } else if (t < 12) { base = WS_VD; pitch = 1024; c = col0 - 2048; }
            else if (t < 14) { base = WS_MQ; pitch = 512; c = col0 - 3072; sc = C2; } else if (t < 16) { base = WS_MK; pitch = 512; c = col0 - 3584; } else { base = WS_MV; pitch = 512; c = col0 - 4096; }
#pragma unroll
            for (int i = 0; i < 8; ++i) v[i] *= sc;
            store8bf((bf16_t*)(ws + base) + (size_t)row * pitch + c, v); } break;
        case EK_GATE: {
            const f32x4 b0 = *(const f32x4*)(aux + col0), b1 = *(const f32x4*)(aux + col0 + 4);
#pragma unroll
            for (int i = 0; i < 8; ++i) { const float z = v[i] + (i < 4 ? b0[i] : b1[i - 4]); v[i] = 1.f / (1.f + __expf(-z)); }
            store8bf(o + (size_t)row * NGATE + col0, v); } break;
        case EK_T: {
            float g[8]; load8bf(gsrc + (size_t)row * NGATE + col0, g);
#pragma unroll
            for (int i = 0; i < 8; ++i) v[i] *= g[i];
            store8bf(o + (size_t)row * DM + col0, v); } break;
        case EK_MIX: {
            { float g[8]; load8bf(gsrc + (size_t)row * NGATE + DM + col0, g);
#pragma unroll
              for (int i = 0; i < 8; ++i) v[i] *= g[i]; }
            asm volatile("" : "+v"(v[0]), "+v"(v[1]), "+v"(v[2]), "+v"(v[3]), "+v"(v[4]), "+v"(v[5]), "+v"(v[6]), "+v"(v[7]) :: "memory");
            { float t[8]; load8bf(o + (size_t)row * DM + col0, t);
#pragma unroll
              for (int i = 0; i < 8; ++i) v[i] += t[i]; }
            store8bf(o + (size_t)row * DM + col0, v); } break;
        case EK_RES: {
            float* p = of + (size_t)row * DM + col0;
            { const f32x4 a = *(const f32x4*)p; *(f32x4*)p = (f32x4){ALPHA * a[0] + v[0], ALPHA * a[1] + v[1], ALPHA * a[2] + v[2], ALPHA * a[3] + v[3]}; }
            asm volatile("" ::: "memory");
            { const f32x4 b = *(const f32x4*)(p + 4); *(f32x4*)(p + 4) = (f32x4){ALPHA * b[0] + v[4], ALPHA * b[1] + v[5], ALPHA * b[2] + v[6], ALPHA * b[3] + v[7]}; } } break;
        case EK_SCALE: {
#pragma unroll
            for (int i = 0; i < 8; ++i) v[i] *= scale;
            store8bf(o + (size_t)row * ldc + col0, v); } break;
        case EK_RELU2: {
#pragma unroll
            for (int i = 0; i < 8; ++i) { const float r = fmaxf(v[i], 0.f); v[i] = r * r; }
            store8bf(o + (size_t)row * ldc + col0, v); } break;
        default: {
            float* p = of + (size_t)row * ldc + col0;
            *(f32x4*)p = (f32x4){v[0], v[1], v[2], v[3]}; *(f32x4*)(p + 4) = (f32x4){v[4], v[5], v[6], v[7]}; } break;
        }
    }
    __device__ __forceinline__ void operator()(const pg8::f32x4 (&acc)[2][2][4][2], const pg8::Unit& u, int wr, int wc, int fr, int fq) const {
#pragma unroll
        for (int ai = 0; ai < 2; ++ai)
#pragma unroll
            for (int m = 0; m < 4; ++m)
#pragma unroll
                for (int bj = 0; bj < 2; ++bj) {
                    const int row = u.pm * 256 + ai * 128 + wr * 64 + m * 16 + fr, col0 = u.pn * 256 + bj * 128 + wc * 32 + 8 * fq;
                    float v[8] = {acc[ai][bj][m][0][0], acc[ai][bj][m][0][1], acc[ai][bj][m][0][2], acc[ai][bj][m][0][3], acc[ai][bj][m][1][0], acc[ai][bj][m][1][1], acc[ai][bj][m][1][2], acc[ai][bj][m][1][3]};
                    put8(row, col0, v); asm volatile("" ::: "memory");
                }
    }
};
struct Ctx { int tid, lane, wave, vcu, G; LAS unsigned char* lds; };

__device__ __forceinline__ void transpose_item(const float* W, int K, int N, bf16_t* WT, LAS float* scr, int item, int lane) {
    const int nblk = N / 32, kb = item / nblk, nb = item % nblk, k0 = 64 * kb, n0 = 32 * nb;
#pragma unroll 8
    for (int i = 0; i < 32; ++i) { const int kk = 2 * i + (lane >> 5); scr[kk * 33 + (lane & 31)] = W[(size_t)(k0 + kk) * N + n0 + (lane & 31)]; }
    asm volatile("s_waitcnt lgkmcnt(0)" ::: "memory");
    const int c = lane & 7;
#pragma unroll
    for (int j = 0; j < 4; ++j) { const int n = (lane >> 3) + 8 * j; const LAS float* s = scr + (8 * c) * 33 + n;
        u32x4 o; o.x = pk2(s[0 * 33], s[1 * 33]); o.y = pk2(s[2 * 33], s[3 * 33]); o.z = pk2(s[4 * 33], s[5 * 33]); o.w = pk2(s[6 * 33], s[7 * 33]);
        *(u32x4*)(WT + (size_t)(n0 + n) * K + k0 + 8 * c) = o; }
    asm volatile("s_waitcnt lgkmcnt(0)" ::: "memory");
}
__device__ __forceinline__ void ln_row(const float* src, const float* g, const float* bb, float* dstf, bf16_t* dstb, int lane) {
    f32x4 v[4]; float s = 0.f;
#pragma unroll
    for (int j = 0; j < 4; ++j) { v[j] = *((const f32x4*)src + lane + 64 * j); s += (v[j][0] + v[j][1]) + (v[j][2] + v[j][3]); }
    const float mean = wave_sum(s) * (1.f / DM); float s2 = 0.f;
#pragma unroll
    for (int j = 0; j < 4; ++j) { v[j] = v[j] - mean; s2 += (v[j][0] * v[j][0] + v[j][1] * v[j][1]) + (v[j][2] * v[j][2] + v[j][3] * v[j][3]); }
    const float rstd = 1.f / sqrtf(wave_sum(s2) * (1.f / DM) + LN_EPS);
#pragma unroll
    for (int j = 0; j < 4; ++j) { const f32x4 gg = *((const f32x4*)g + lane + 64 * j), b4 = *((const f32x4*)bb + lane + 64 * j); const f32x4 o = v[j] * rstd * gg + b4;
        if (dstf) *((f32x4*)dstf + lane + 64 * j) = o;
        if (dstb) { u32x2 w; w.x = pk2(o[0], o[1]); w.y = pk2(o[2], o[3]); *((u32x2*)dstb + lane + 64 * j) = w; } }
}
__device__ __forceinline__ void ln_row2(const float* src, size_t stride, const float* g, const float* bb, float* dstf, bf16_t* dstb, int lane) {
    f32x4 v[2][4]; float s[2] = {0.f, 0.f};
#pragma unroll
    for (int q = 0; q < 2; ++q)
#pragma unroll
        for (int j = 0; j < 4; ++j) v[q][j] = *((const f32x4*)(src + q * stride) + lane + 64 * j);
#pragma unroll
    for (int q = 0; q < 2; ++q)
#pragma unroll
        for (int j = 0; j < 4; ++j) s[q] += (v[q][j][0] + v[q][j][1]) + (v[q][j][2] + v[q][j][3]);
    float mean[2], rstd[2];
#pragma unroll
    for (int q = 0; q < 2; ++q) { mean[q] = wave_sum(s[q]) * (1.f / DM); float s2 = 0.f;
#pragma unroll
        for (int j = 0; j < 4; ++j) { v[q][j] = v[q][j] - mean[q]; s2 += (v[q][j][0] * v[q][j][0] + v[q][j][1] * v[q][j][1]) + (v[q][j][2] * v[q][j][2] + v[q][j][3] * v[q][j][3]); }
        rstd[q] = 1.f / sqrtf(wave_sum(s2) * (1.f / DM) + LN_EPS); }
#pragma unroll
    for (int j = 0; j < 4; ++j) { const f32x4 gg = *((const f32x4*)g + lane + 64 * j), b4 = *((const f32x4*)bb + lane + 64 * j);
#pragma unroll
        for (int q = 0; q < 2; ++q) { const f32x4 o = v[q][j] * rstd[q] * gg + b4;
            if (dstf) *((f32x4*)(dstf + q * stride) + lane + 64 * j) = o;
            if (dstb) { u32x2 w; w.x = pk2(o[0], o[1]); w.y = pk2(o[2], o[3]); *((u32x2*)(dstb + q * stride) + lane + 64 * j) = w; } } }
}
__device__ __forceinline__ int rel_bucket(int n) {
    if (n < 16) return n;
    int l = 16 + (int)(logf((float)n / 16.f) / logf(8.f) * 16.f);
    return l < 31 ? l : 31;
}

__device__ __forceinline__ void naive_diff(const Ctx& C, unsigned char* ws) {
    const bf16_t* Qd = (const bf16_t*)(ws + WS_QD); const bf16_t* Kd = (const bf16_t*)(ws + WS_KD); const bf16_t* Vd = (const bf16_t*)(ws + WS_VD);
    bf16_t* O2 = (bf16_t*)(ws + WS_HB); const float* BIAS2 = (const float*)(ws + WS_TAB);
    const int gw = C.vcu * NWAVES + C.wave, NGW = C.G * NWAVES;
    for (int wi0 = gw; wi0 < 16384; wi0 += NGW) {
        const int wi1 = __builtin_amdgcn_readfirstlane(wi0); const int vh = wi1 & 1, wi = wi1 >> 1;
        const int pass = wi1 / NGW; const int qblk = (pass & 1) ? 255 - (wi & 255) : (wi & 255); const int hm = (wi >> 8) & 15, b = wi >> 12, h = hm >> 1;
        const int q = qblk * 64 + C.lane; const size_t rb = (size_t)b * SEQ;
        float qf[64];
        { const u32x4* qp = (const u32x4*)(Qd + (rb + q) * 1024 + hm * 64);
#pragma unroll
          for (int i = 0; i < 8; ++i) { const u32x4 w = qp[i]; qf[8 * i] = bflo(w.x); qf[8 * i + 1] = bfhi(w.x); qf[8 * i + 2] = bflo(w.y); qf[8 * i + 3] = bfhi(w.y); qf[8 * i + 4] = bflo(w.z); qf[8 * i + 5] = bfhi(w.z); qf[8 * i + 6] = bflo(w.w); qf[8 * i + 7] = bfhi(w.w); } }
        float o[64];
#pragma unroll
        for (int j = 0; j < 64; ++j) o[j] = 0.f;
        float mx = -1e30f, l = 0.f; const float* bt = BIAS2 + h * BIASW; const float b31 = bt[BIASW - 1];
        const int kend = qblk * 64 + 63;
        for (int k = 0; k <= kend; ++k) {
            const unsigned* kr = (const unsigned*)(Kd + (rb + k) * 1024 + hm * 64);
            float s0 = 0.f, s1 = 0.f;
#pragma unroll
            for (int j = 0; j < 32; ++j) { const unsigned u = kr[j]; s0 += qf[2 * j] * bflo(u); s1 += qf[2 * j + 1] * bfhi(u); }
            const int d = q - k; float s = s0 + s1;
            s += (d < BIASW) ? bt[d < 0 ? 0 : d] : b31;
            if (d >= 0) {
                if (s > mx) { const float f = __builtin_amdgcn_exp2f(mx - s); l *= f;
#pragma unroll
                    for (int j = 0; j < 64; ++j) o[j] *= f;
                    mx = s; }
                const float p = __builtin_amdgcn_exp2f(s - mx); l += p;
                const unsigned* vr = (const unsigned*)(Vd + (rb + k) * 1024 + h * 128 + vh * 64);
#pragma unroll
                for (int j = 0; j < 32; ++j) { const unsigned u = vr[j]; o[2 * j] += p * bflo(u); o[2 * j + 1] += p * bfhi(u); }
            }
        }
        const float rl = 1.f / l; unsigned* op = (unsigned*)(O2 + (rb + q) * 2048 + hm * 128 + vh * 64);
#pragma unroll
        for (int j = 0; j < 32; ++j) op[j] = pk2(o[2 * j] * rl, o[2 * j + 1] * rl);
    }
}
__device__ __forceinline__ void naive_moba(const Ctx& C, unsigned char* ws) {
    bf16_t* Mq = (bf16_t*)(ws + WS_MQ); const bf16_t* Mk = (const bf16_t*)(ws + WS_MK); const bf16_t* Mv = (const bf16_t*)(ws + WS_MV);
    const bf16_t* KM = (const bf16_t*)(ws + WS_KMEAN); const float* BIAS2 = (const float*)(ws + WS_TAB);
    const int gw = C.vcu * NWAVES + C.wave, NGW = C.G * NWAVES;
    for (int wi0 = gw; wi0 < 4096; wi0 += NGW) {
        const int wi = __builtin_amdgcn_readfirstlane(wi0);
        const int qblk = wi & 255, h = (wi >> 8) & 7, b = wi >> 11, cur = qblk >> 2;
        const int q = qblk * 64 + C.lane; const size_t rb = (size_t)b * SEQ;
        float qf[64];
        { const u32x4* qp = (const u32x4*)(Mq + (rb + q) * 512 + h * 64);
#pragma unroll
          for (int i = 0; i < 8; ++i) { const u32x4 w = qp[i]; qf[8 * i] = bflo(w.x); qf[8 * i + 1] = bfhi(w.x); qf[8 * i + 2] = bflo(w.y); qf[8 * i + 3] = bfhi(w.y); qf[8 * i + 4] = bflo(w.z); qf[8 * i + 5] = bfhi(w.z); qf[8 * i + 6] = bflo(w.w); qf[8 * i + 7] = bfhi(w.w); } }
        float v0 = -INFINITY, v1 = -INFINITY, v2 = -INFINITY; int i0 = -1, i1 = -1, i2 = -1;
        for (int n = 0; n < cur; ++n) {
            const unsigned* kr = (const unsigned*)(KM + ((size_t)(b * 8 + h) * 64 + n) * 64);
            float g0 = 0.f, g1 = 0.f;
#pragma unroll
            for (int j = 0; j < 32; ++j) { const unsigned u = kr[j]; g0 += qf[2 * j] * bflo(u); g1 += qf[2 * j + 1] * bfhi(u); }
            const float g = g0 + g1;
            if (g > v0) { v2 = v1; i2 = i1; v1 = v0; i1 = i0; v0 = g; i0 = n; } else if (g > v1) { v2 = v1; i2 = i1; v1 = g; i1 = n; } else if (g > v2) { v2 = g; i2 = n; }
        }
        float o[64];
#pragma unroll
        for (int j = 0; j < 64; ++j) o[j] = 0.f;
        float mx = -1e30f, l = 0.f; const float* bt = BIAS2 + (8 + h) * BIASW; const float b31 = bt[BIASW - 1];
        for (int slot = 0; slot < 3; ++slot) {
            const int blk = slot == 0 ? i0 : (slot == 1 ? i1 : i2);
            if (slot < cur) {
                for (int kk = 0; kk < 256; ++kk) {
                    const int kpos = blk * 256 + kk;
                    const unsigned* kr = (const unsigned*)(Mk + (rb + kpos) * 512 + h * 64);
                    float s0 = 0.f, s1 = 0.f;
#pragma unroll
                    for (int j = 0; j < 32; ++j) { const unsigned u = kr[j]; s0 += qf[2 * j] * bflo(u); s1 += qf[2 * j + 1] * bfhi(u); }
                    const int d = q - kpos; float s = s0 + s1; s += (d < BIASW) ? bt[d] : b31;
                    if (s > mx) { const float f = __builtin_amdgcn_exp2f(mx - s); l *= f;
#pragma unroll
                        for (int j = 0; j < 64; ++j) o[j] *= f;
                        mx = s; }
                    const float p = __builtin_amdgcn_exp2f(s - mx); l += p;
                    const unsigned* vr = (const unsigned*)(Mv + (rb + kpos) * 512 + h * 64);
#pragma unroll
                    for (int j = 0; j < 32; ++j) { const unsigned u = vr[j]; o[2 * j] += p * bflo(u); o[2 * j + 1] += p * bfhi(u); }
                }
            }
        }
        const int kend = qblk * 64 + 63;
        for (int kpos = cur * 256; kpos <= kend; ++kpos) {
            const unsigned* kr = (const unsigned*)(Mk + (rb + kpos) * 512 + h * 64);
            float s0 = 0.f, s1 = 0.f;
#pragma unroll
            for (int j = 0; j < 32; ++j) { const unsigned u = kr[j]; s0 += qf[2 * j] * bflo(u); s1 += qf[2 * j + 1] * bfhi(u); }
            const int d = q - kpos; float s = s0 + s1; s += bt[d < 0 ? 0 : d];
            if (d >= 0) {
                if (s > mx) { const float f = __builtin_amdgcn_exp2f(mx - s); l *= f;
#pragma unroll
                    for (int j = 0; j < 64; ++j) o[j] *= f;
                    mx = s; }
                const float p = __builtin_amdgcn_exp2f(s - mx); l += p;
                const unsigned* vr = (const unsigned*)(Mv + (rb + kpos) * 512 + h * 64);
#pragma unroll
                for (int j = 0; j < 32; ++j) { const unsigned u = vr[j]; o[2 * j] += p * bflo(u); o[2 * j + 1] += p * bfhi(u); }
            }
        }
        const float rl = 1.f / l; unsigned* op = (unsigned*)(Mq + (rb + q) * 512 + h * 64);
#pragma unroll
        for (int j = 0; j < 32; ++j) op[j] = pk2(o[2 * j] * rl, o[2 * j + 1] * rl);
    }
}
#ifndef NAIVE_ATTN
#define NAIVE_ATTN 0
#endif
#ifndef DUPMASK
#define DUPMASK 0
#endif
#ifndef EXTRA_BARS
#define EXTRA_BARS 0
#endif
struct Args { const float* in[27]; float* out; unsigned char* ws; int lo, hi; };
enum { IN_X = 0, IN_MEM, IN_LNG, IN_LNB, IN_REL, IN_WIN, IN_BG, IN_LQ1, IN_LK1, IN_LQ2, IN_LK2, IN_SUBG, IN_WBD, IN_WBM, IN_WOUT, IN_LN1G, IN_LN1B, IN_WQ, IN_WK, IN_WV, IN_WO, IN_LN2G, IN_LN2B, IN_W1, IN_W2, IN_LN3G, IN_LN3B };
constexpr int NSTEPS = 20;
__host__ __device__ constexpr bool sync_after(int s) { return !(s == 1 || s == 2 || s == 7); }

__device__ __forceinline__ void grid_bar(unsigned* ctr, unsigned target, int wave_s) {
    asm volatile("s_waitcnt vmcnt(0)" ::: "memory");
    __syncthreads();
    if (wave_s == 0 && fresh_lane() == 0) {
        __builtin_amdgcn_fence(__ATOMIC_RELEASE, "agent");
        asm volatile("s_waitcnt vmcnt(0)" ::: "memory");
        __hip_atomic_fetch_add(ctr, 1u, __ATOMIC_RELAXED, __HIP_MEMORY_SCOPE_AGENT);
        unsigned spins = 0;
        while (__hip_atomic_load(ctr, __ATOMIC_RELAXED, __HIP_MEMORY_SCOPE_AGENT) < target) { __builtin_amdgcn_s_sleep(1); if (++spins > (1u << 27)) break; }
        __builtin_amdgcn_fence(__ATOMIC_ACQUIRE, "agent");
        asm volatile("s_waitcnt vmcnt(0)" ::: "memory");
    }
    __syncthreads();
}
__global__ void __launch_bounds__(NWAVES * 64, 2) fwd(Args args) {
    extern __shared__ __attribute__((aligned(16))) unsigned char lds_raw[];
    cg::grid_group grid = cg::this_grid();
    Ctx C; C.lds = (LAS unsigned char*)lds_raw; const int wave_s = __builtin_amdgcn_readfirstlane((int)threadIdx.x >> 6);
#define RECTX() do { int t_ = wave_s * 64 + fresh_lane(); asm volatile("" : "+v"(t_)); C.tid = t_; C.lane = t_ & 63; C.wave = __builtin_amdgcn_readfirstlane(t_ >> 6); gw = C.vcu * NWAVES + C.wave; } while (0)
    C.G = gridDim.x; { const int bx = blockIdx.x; C.vcu = (C.G % 8 == 0) ? (bx % 8) * (C.G / 8) + bx / 8 : bx; }
    unsigned char* ws = args.ws; float* out = args.out;
    int gw = 0; const int NGW = C.G * NWAVES;
    bf16_t* HB = (bf16_t*)(ws + WS_HB);
    const int lo = args.lo, hi = args.hi; unsigned nbar = 0;
    if (lo < 0) grid.sync();
#define IN(k) (lo <= (k) && (k) < hi)
#define SEAM(k) do { if ((k) == 4 && hi - lo > 1) { for (int xb_ = 0; xb_ < EXTRA_BARS; ++xb_) { ++nbar; grid_bar((unsigned*)ws, nbar * (unsigned)C.G, wave_s); } } if ((k) + 1 < hi) { if (!sync_after(k)) __syncthreads(); else { ++nbar; grid_bar((unsigned*)ws, nbar * (unsigned)C.G, wave_s); } } } while (0)
#define GEMM(k, KK, LDA, LDB, APN, BPN, BPM, DIV, Ap, Bp, MM, NN, KIND, SETUP) if (IN(k)) { pg8::GemmT<KK, LDA, LDB, APN, BPN, BPM, DIV> g{Ap, Bp, MM, NN}; Epi<KIND> E{}; E.ws = ws; SETUP; \
        pg8::StaticOrder S; S.init(MM, NN, C.G, ((k) == 3) ? (int)((blockIdx.x + gridDim.x - 8) % gridDim.x) : (int)blockIdx.x);     _Pragma("unroll 1") for (int rep_ = 0; rep_ < 1 + ((DUPMASK >> (k)) & 1); ++rep_) { pg8::gemm_phase<Epi<KIND>, pg8::StaticOrder, ((k) != 14) && PG8_ALIGN, PG8_SP2>(C.lds, g, S, E, wave_s); __syncthreads(); } SEAM(k); }
    if (IN(0)) { RECTX();
            LAS float* scr = (LAS float*)(C.lds + C.wave * 16384);
            const float* Ws[10] = {args.in[IN_WIN], args.in[IN_WBD], args.in[IN_WBM], args.in[IN_WOUT], args.in[IN_WQ], args.in[IN_WK], args.in[IN_WV], args.in[IN_WO], args.in[IN_W1], args.in[IN_W2]};
            const int Ks[10] = {1024, 1024, 512, 1024, 1024, 1024, 1024, 1024, 1024, 4096}, Ns[10] = {NIN, 1024, 1024, 1024, 1024, 1024, 1024, 1024, 4096, 1024};
            const size_t Os[10] = {WS_WIN, WS_WBD, WS_WBM, WS_WOUT, WS_WQ, WS_WK, WS_WV, WS_WO, WS_W1, WS_W2};
#pragma unroll
            for (int w = 0; w < 10; ++w) { const int nit = (Ks[w] / 64) * (Ns[w] / 32);
                for (int it = gw; it < nit; it += NGW) transpose_item(Ws[w], Ks[w], Ns[w], (bf16_t*)(ws + Os[w]), scr, it, C.lane); }
            for (int m = gw; m < MTOK; m += 2 * NGW) { if (m + NGW < MTOK) ln_row2(args.in[IN_X] + (size_t)m * DM, (size_t)NGW * DM, args.in[IN_LNG], args.in[IN_LNB], out + (size_t)m * DM, HB + (size_t)m * DM, C.lane); else ln_row(args.in[IN_X] + (size_t)m * DM, args.in[IN_LNG], args.in[IN_LNB], out + (size_t)m * DM, HB + (size_t)m * DM, C.lane); }
            { const float* mem = args.in[IN_MEM]; unsigned* mb = (unsigned*)(ws + WS_MEMB);
              for (int i = blockIdx.x * 512 + C.tid; i < BATCH * NMEM * DM / 2; i += C.G * 512) mb[i] = pk2(mem[2 * i], mem[2 * i + 1]); }
            { float* tb = (float*)(ws + WS_TAB); const float* rel = args.in[IN_REL];
              for (int i = blockIdx.x * 512 + C.tid; i < 16 * BIASW; i += C.G * 512) { const int h = i / BIASW, d = i % BIASW; tb[i] = rel[rel_bucket(d) * 16 + h] * LOG2E; } }
            SEAM(0); }
    GEMM(1, 1024, 1024, 1024, 0, 256 * 1024, 0, 1, HB, (const bf16_t*)(ws + WS_WIN), MTOK, NPROJ, EK_PROJ, (void)0)
    GEMM(2, 1024, 1024, 1024, 0, 256 * 1024, 0, 1, (const bf16_t*)(ws + WS_MEMB), (const bf16_t*)(ws + WS_WK), BATCH * NMEM, 1024, EK_SCALE, (E.scale = 1.f, E.o = (bf16_t*)(ws + WS_KX), E.ldc = 1024))
    GEMM(3, 1024, 1024, 1024, 0, 256 * 1024, 0, 1, (const bf16_t*)(ws + WS_WV), (const bf16_t*)(ws + WS_MEMB), 1024, BATCH * NMEM, EK_SCALE, (E.scale = 1.f, E.o = (bf16_t*)(ws + WS_VXT), E.ldc = 1024))
    if (IN(4)) { RECTX();
            { const bf16_t* Mk = (const bf16_t*)(ws + WS_MK); bf16_t* KM = (bf16_t*)(ws + WS_KMEAN);
              for (int blk = gw; blk < BATCH * 8 * 64; blk += NGW) { const int n = blk & 63, h = (blk >> 6) & 7, b = blk >> 9;
                  const bf16_t* p = Mk + ((size_t)b * SEQ + n * 256 + (C.lane >> 3)) * 512 + h * 64 + (C.lane & 7) * 8; float a[8];
#pragma unroll
                  for (int j = 0; j < 8; ++j) a[j] = 0.f;
#pragma unroll 8
                  for (int r = 0; r < 32; ++r) { float v[8]; load8bf(p + (size_t)r * 8 * 512, v);
#pragma unroll
                      for (int j = 0; j < 8; ++j) a[j] += v[j]; }
#pragma unroll
                  for (int j = 0; j < 8; ++j) { a[j] += __shfl_xor(a[j], 8); a[j] += __shfl_xor(a[j], 16); a[j] += __shfl_xor(a[j], 32); a[j] *= (1.f / 256.f); }
                  if (C.lane < 8) store8bf(KM + (size_t)blk * 64 + C.lane * 8, a); } }
            __syncthreads();
#if NAIVE_ATTN
            naive_diff(C, ws);
#else
            { const attn_body::bf16* Qd = (const attn_body::bf16*)(ws + WS_QD); const attn_body::bf16* Kd = (const attn_body::bf16*)(ws + WS_KD); const attn_body::bf16* Vd = (const attn_body::bf16*)(ws + WS_VD);
              const float* BIAS2 = (const float*)(ws + WS_TAB);
              const float lam_v = expf(wave_sum(args.in[IN_LQ1][C.lane] * args.in[IN_LK1][C.lane])) - expf(wave_sum(args.in[IN_LQ2][C.lane] * args.in[IN_LK2][C.lane])) + LAM_INIT;
              const float lam = __builtin_bit_cast(float, __builtin_amdgcn_readfirstlane(__builtin_bit_cast(int, lam_v)));
              attn_body::bf16* O1T = (attn_body::bf16*)(ws + WS_X1); attn_body::bf16* OD = (attn_body::bf16*)(ws + WS_QD);
              for (int i = 0;; ++i) {
                  int combo, qb;
                  if (C.G == 256) { if (i >= 4) break; const int s = C.vcu & 15; combo = C.vcu >> 4; qb = (i == 0) ? s : (i == 1) ? 31 - s : (i == 2) ? 32 + s : 63 - s; }
                  else { const int u = C.vcu + i * C.G; if (u >= 1024) break; combo = u >> 6; qb = u & 63; }
                  const int b = combo >> 3, h = combo & 7;
#pragma unroll 1
                  for (int m = 0; m < 2; ++m)
                      attn_body::attn_unit128<8, 1024, 1024, 1024, 1024>(b, qb, Qd + (2 * h + m) * 64, Kd + (2 * h + m) * 64, Vd + h * 128, OD + h * 128, (char*)lds_raw, BIAS2 + h * BIASW, wave_s, O1T + h * 128, m, lam, args.in[IN_SUBG]);
              } }
#endif
            SEAM(4); }
    if (IN(5)) { RECTX();
            __syncthreads();
#if NAIVE_ATTN
            naive_moba(C, ws);
#else
            { attn_body::bf16* Mq = (attn_body::bf16*)(ws + WS_MQ); const attn_body::bf16* Mk = (const attn_body::bf16*)(ws + WS_MK); const attn_body::bf16* Mv = (const attn_body::bf16*)(ws + WS_MV);
              const attn_body::bf16* KM = (const attn_body::bf16*)(ws + WS_KMEAN); const float* BIAS2 = (const float*)(ws + WS_TAB);
              for (int i = 0;; ++i) {
                  int combo, qb;
                  if (C.G == 256) { if (i >= 4) break; const int s = C.vcu & 15; combo = C.vcu >> 4; qb = (i == 0) ? s : (i == 1) ? 31 - s : (i == 2) ? 32 + s : 63 - s; }
                  else { const int u = C.vcu + i * C.G; if (u >= 1024) break; combo = u >> 6; qb = u & 63; }
                  const int b = combo >> 3, h = combo & 7;
                  attn_body::attn_unit<8, 1, 512, 512, 512, 512>(b, qb, Mq + h * 64, Mk + h * 64, Mv + h * 64, Mq + h * 64, (char*)lds_raw, BIAS2 + (8 + h) * BIASW, KM + (size_t)(b * 8 + h) * 4096, wave_s);
              } }
#endif
            SEAM(5); }
    GEMM(6, 1024, 1024, 1024, 0, 256 * 1024, 0, 1, HB, (const bf16_t*)(ws + WS_WIN) + (size_t)NPROJ * 1024, MTOK, NGATE, EK_GATE, (E.o = (bf16_t*)(ws + WS_KD), E.aux = args.in[IN_BG]))
    GEMM(7, 1024, 1024, 1024, 0, 256 * 1024, 0, 1, (const bf16_t*)(ws + WS_QD), (const bf16_t*)(ws + WS_WBD), MTOK, 1024, EK_T, (E.o = (bf16_t*)(ws + WS_X1), E.gsrc = (const bf16_t*)(ws + WS_KD)))
    GEMM(8, 512, 512, 512, 0, 256 * 512, 0, 1, (const bf16_t*)(ws + WS_MQ), (const bf16_t*)(ws + WS_WBM), MTOK, 1024, EK_MIX, (E.o = (bf16_t*)(ws + WS_X1), E.gsrc = (const bf16_t*)(ws + WS_KD)))
    GEMM(9, 1024, 1024, 1024, 0, 256 * 1024, 0, 1, (const bf16_t*)(ws + WS_X1), (const bf16_t*)(ws + WS_WOUT), MTOK, 1024, EK_RES, (E.of = out))
    if (IN(10)) { RECTX(); for (int m = gw; m < MTOK; m += 2 * NGW) { if (m + NGW < MTOK) ln_row2(out + (size_t)m * DM, (size_t)NGW * DM, args.in[IN_LN1G], args.in[IN_LN1B], out + (size_t)m * DM, HB + (size_t)m * DM, C.lane); else ln_row(out + (size_t)m * DM, args.in[IN_LN1G], args.in[IN_LN1B], out + (size_t)m * DM, HB + (size_t)m * DM, C.lane); } SEAM(10); }
    GEMM(11, 1024, 1024, 1024, 0, 256 * 1024, 0, 1, HB, (const bf16_t*)(ws + WS_WQ), MTOK, 1024, EK_SCALE, (E.scale = XC2, E.o = (bf16_t*)(ws + WS_QD), E.ldc = 1024))
    GEMM(12, 256, 1024, 1024, 256, 256, 256 * 1024, 64, (const bf16_t*)(ws + WS_QD), (const bf16_t*)(ws + WS_KX), MTOK, 1024, EK_F32, (E.of = (float*)(ws + WS_HB), E.ldc = 1024))
    if (IN(13)) { RECTX();
            const float* SF = (const float*)(ws + WS_HB); bf16_t* P = (bf16_t*)(ws + WS_KD);
            for (int m = gw; m < MTOK; m += NGW) {
                f32x4 v[4];
#pragma unroll
                for (int j = 0; j < 4; ++j) v[j] = *((const f32x4*)(SF + (size_t)m * DM) + C.lane + 64 * j);
#pragma unroll
                for (int j = 0; j < 4; ++j) { float mx = fmaxf(fmaxf(v[j][0], v[j][1]), fmaxf(v[j][2], v[j][3]));
#pragma unroll
                    for (int o = 1; o < 64; o <<= 1) mx = fmaxf(mx, __shfl_xor(mx, o));
                    f32x4 e; e[0] = __builtin_amdgcn_exp2f(v[j][0] - mx); e[1] = __builtin_amdgcn_exp2f(v[j][1] - mx); e[2] = __builtin_amdgcn_exp2f(v[j][2] - mx); e[3] = __builtin_amdgcn_exp2f(v[j][3] - mx);
                    const float rl = 1.f / wave_sum((e[0] + e[1]) + (e[2] + e[3]));
                    u32x2 w; w.x = pk2(e[0] * rl, e[1] * rl); w.y = pk2(e[2] * rl, e[3] * rl); *((u32x2*)(P + (size_t)m * DM) + C.lane + 64 * j) = w; }
            }
            SEAM(13); }
    GEMM(14, 256, 1024, 1024, 256, 256 * 1024, 256, 64, (const bf16_t*)(ws + WS_KD), (const bf16_t*)(ws + WS_VXT), MTOK, 1024, EK_SCALE, (E.scale = 1.f, E.o = (bf16_t*)(ws + WS_VD), E.ldc = 1024))
    GEMM(15, 1024, 1024, 1024, 0, 256 * 1024, 0, 1, (const bf16_t*)(ws + WS_VD), (const bf16_t*)(ws + WS_WO), MTOK, 1024, EK_RES, (E.of = out))
    if (IN(16)) { RECTX(); for (int m = gw; m < MTOK; m += 2 * NGW) { if (m + NGW < MTOK) ln_row2(out + (size_t)m * DM, (size_t)NGW * DM, args.in[IN_LN2G], args.in[IN_LN2B], out + (size_t)m * DM, HB + (size_t)m * DM, C.lane); else ln_row(out + (size_t)m * DM, args.in[IN_LN2G], args.in[IN_LN2B], out + (size_t)m * DM, HB + (size_t)m * DM, C.lane); } SEAM(16); }
    GEMM(17, 1024, 1024, 1024, 0, 256 * 1024, 0, 1, HB, (const bf16_t*)(ws + WS_W1), MTOK, FF, EK_RELU2, (E.o = (bf16_t*)(ws + WS_X1), E.ldc = FF))
    GEMM(18, FF, FF, FF, 0, 256 * FF, 0, 1, (const bf16_t*)(ws + WS_X1), (const bf16_t*)(ws + WS_W2), MTOK, 1024, EK_RES, (E.of = out))
    if (IN(19)) { RECTX(); for (int m = gw; m < MTOK; m += 2 * NGW) { if (m + NGW < MTOK) ln_row2(out + (size_t)m * DM, (size_t)NGW * DM, args.in[IN_LN3G], args.in[IN_LN3B], out + (size_t)m * DM, nullptr, C.lane); else ln_row(out + (size_t)m * DM, args.in[IN_LN3G], args.in[IN_LN3B], out + (size_t)m * DM, nullptr, C.lane); } }
}

#ifndef NAIVE_ATTN
#define NAIVE_ATTN 0
#endif
#ifndef N_LAUNCH_MODE
#define N_LAUNCH_MODE 1
#endif
extern "C" void kernel_launch(void* const* d_in, const int* in_sizes, int n_in, void* d_out, int out_size, void* d_ws, size_t ws_size, hipStream_t stream) {
    static int grid = 0;
    if (grid == 0) {
        if (n_in != 27 || out_size != MTOK * DM || ws_size < WS_END) { fprintf(stderr, "kernel_launch: unexpected shapes (n_in %d out %d ws %zu)\n", n_in, out_size, ws_size); grid = -1; return; }
        int dev = 0, cus = 0, per_cu = 0;
        hipGetDevice(&dev); hipDeviceGetAttribute(&cus, hipDeviceAttributeMultiprocessorCount, dev);
        if (hipFuncSetAttribute((const void*)fwd, hipFuncAttributeMaxDynamicSharedMemorySize, LDS_BYTES) != hipSuccess) { fprintf(stderr, "kernel_launch: hipFuncSetAttribute failed\n"); grid = -1; return; }
        hipOccupancyMaxActiveBlocksPerMultiprocessor(&per_cu, (const void*)fwd, NWAVES * 64, LDS_BYTES);
        (void)hipGetLastError();
        if (per_cu < 1) fprintf(stderr, "kernel_launch: occupancy query says %d blocks/CU\n", per_cu);
        grid = cus > 0 ? cus : 256;
    }
    if (grid < 0) return;
    (void)hipMemsetAsync(d_ws, 0, 256, stream);
    Args a{};
    for (int i = 0; i < 27; ++i) a.in[i] = (const float*)d_in[i];
    a.out = (float*)d_out; a.ws = (unsigned char*)d_ws;
#if N_LAUNCH_MODE == 1
    a.lo = 0; a.hi = NSTEPS;
    void* kargs[] = {&a};
    hipError_t e = hipLaunchCooperativeKernel((const void*)fwd, dim3(grid), dim3(NWAVES * 64), kargs, LDS_BYTES, stream);
    if (e != hipSuccess) fprintf(stderr, "cooperative launch failed: %s (grid %d)\n", hipGetErrorString(e), grid);
#else
    int lo = 0;
    for (int s = 0; s < NSTEPS; ++s) if (sync_after(s) || s == NSTEPS - 1) { a.lo = lo; a.hi = s + 1; hipLaunchKernelGGL(fwd, dim3(grid), dim3(NWAVES * 64), LDS_BYTES, stream, a); lo = s + 1; }
#endif
}
```
